# Optimizing an MI355X kernel written in HIP

```python
import math
import jax, jax.numpy as jnp
from jax import lax
import numpy as np

D_MODEL = 1024
BATCH = 8
SEQ = 2048
DEPTH = 4

N_A_LAYERS = DEPTH // 2
N_B_LAYERS = DEPTH - N_A_LAYERS
D_FF = 256 * ((8 * D_MODEL // 3 + 255) // 256)
CONV_WIDTH = 3
HEAD_DIM = 64
N_HEADS = D_MODEL // (2 * HEAD_DIM)
Q_BLOCK = 128
EPS = 1e-6
LAMBDA_STD = 0.1

kernel_name = "yoco_shortconv_diffattn_macaron"


def rms_norm(x, g):
    xf = x.astype(jnp.float32)
    y = xf * lax.rsqrt(jnp.mean(xf * xf, axis=-1, keepdims=True) + EPS)
    return (y * g.astype(jnp.float32)).astype(x.dtype)


def swiglu(h, w_gate, w_up, w_down):
    return (jax.nn.silu(h @ w_gate) * (h @ w_up)) @ w_down


def short_conv_mixer(h, w_in, w_conv, w_out):
    gate_b, gate_c, u = jnp.split(h @ w_in, 3, axis=-1)
    z = lax.conv_general_dilated(
        gate_c * u, w_conv[:, None, :], window_strides=(1,),
        padding=[(CONV_WIDTH - 1, 0)], dimension_numbers=("NWC", "WIO", "NWC"),
        feature_group_count=D_MODEL)
    return (gate_b * z) @ w_out


def shared_kv(x, g_kv, w_kv):
    b, s, _ = x.shape
    k, v = jnp.split(rms_norm(x, g_kv) @ w_kv, 2, axis=-1)
    k = k.reshape(b, s, N_HEADS, 2, HEAD_DIM)
    v = v.reshape(b, s, N_HEADS, 2 * HEAD_DIM)
    return k, v


def diff_attention(h, k, v, w_q, lq1, lk1, lq2, lk2, g_subln, w_o, lambda_init):
    b, s, _ = h.shape
    q = (h @ w_q).reshape(b, s, N_HEADS, 2, HEAD_DIM) * (HEAD_DIM ** -0.5)
    f32 = jnp.float32
    lam = (jnp.exp(jnp.sum(lq1.astype(f32) * lk1.astype(f32)))
           - jnp.exp(jnp.sum(lq2.astype(f32) * lk2.astype(f32))) + lambda_init)
    n_blocks = s // Q_BLOCK
    q_blocks = jnp.moveaxis(q.reshape(b, n_blocks, Q_BLOCK, N_HEADS, 2, HEAD_DIM), 1, 0)
    key_pos = jnp.arange(s)

    def block(args):
        qb, i = args
        scores = jnp.einsum("bqhcd,bkhcd->bhcqk", qb, k).astype(f32)
        q_pos = i * Q_BLOCK + jnp.arange(Q_BLOCK)
        causal = key_pos[None, :] <= q_pos[:, None]
        p = jax.nn.softmax(jnp.where(causal, scores, -jnp.inf), axis=-1)
        a = p[:, :, 0] - lam * p[:, :, 1]
        return jnp.einsum("bhqk,bkhe->bqhe", a.astype(v.dtype), v)

    o = lax.map(block, (q_blocks, jnp.arange(n_blocks)))
    o = jnp.moveaxis(o, 0, 1).reshape(b, s, N_HEADS, 2 * HEAD_DIM)
    o = rms_norm(o, g_subln) * (1.0 - lambda_init)
    return o.reshape(b, s, D_MODEL) @ w_o


def setup_inputs(seed: int = 0) -> dict:
    key = jax.random.key(seed)
    ks = jax.random.split(key, 20)
    f32 = jnp.float32
    nrm = lambda k, shape, fan_in: jax.random.normal(k, shape, f32) * (fan_in ** -0.5)
    return {
        "x": jax.random.normal(ks[0], (BATCH, SEQ, D_MODEL), f32),
        "g_norm": 1.0 + 0.02 * jax.random.normal(ks[1], (DEPTH, 6, D_MODEL), f32),
        "w_ffn_gate": nrm(ks[2], (DEPTH, 2, D_MODEL, D_FF), D_MODEL),
        "w_ffn_up": nrm(ks[3], (DEPTH, 2, D_MODEL, D_FF), D_MODEL),
        "w_ffn_down": nrm(ks[4], (DEPTH, 2, D_FF, D_MODEL), D_FF),
        "w_conv_in": nrm(ks[5], (N_A_LAYERS, D_MODEL, 3 * D_MODEL), D_MODEL),
        "w_conv": nrm(ks[6], (N_A_LAYERS, CONV_WIDTH, D_MODEL), CONV_WIDTH),
        "w_conv_out": nrm(ks[7], (N_A_LAYERS, D_MODEL, D_MODEL), D_MODEL),
        "g_kv": 1.0 + 0.02 * jax.random.normal(ks[8], (D_MODEL,), f32),
        "w_kv": nrm(ks[9], (D_MODEL, 2 * D_MODEL), D_MODEL),
        "w_q": nrm(ks[10], (N_B_LAYERS, D_MODEL, D_MODEL), D_MODEL),
        "lambda_q1": LAMBDA_STD * jax.random.normal(ks[11], (N_B_LAYERS, HEAD_DIM), f32),
        "lambda_k1": LAMBDA_STD * jax.random.normal(ks[12], (N_B_LAYERS, HEAD_DIM), f32),
        "lambda_q2": LAMBDA_STD * jax.random.normal(ks[13], (N_B_LAYERS, HEAD_DIM), f32),
        "lambda_k2": LAMBDA_STD * jax.random.normal(ks[14], (N_B_LAYERS, HEAD_DIM), f32),
        "g_subln": 1.0 + 0.02 * jax.random.normal(ks[15], (N_B_LAYERS, 2 * HEAD_DIM), f32),
        "w_o": nrm(ks[16], (N_B_LAYERS, D_MODEL, D_MODEL), D_MODEL),
    }


def reference(x, g_norm, w_ffn_gate, w_ffn_up, w_ffn_down, w_conv_in, w_conv, w_conv_out,
              g_kv, w_kv, w_q, lambda_q1, lambda_k1, lambda_q2, lambda_k2, g_subln, w_o):
    k = v = None
    for layer in range(DEPTH):
        g = g_norm[layer]
        f = swiglu(rms_norm(x, g[0]), w_ffn_gate[layer, 0], w_ffn_up[layer, 0], w_ffn_down[layer, 0])
        x = x + 0.5 * rms_norm(f, g[1])
        h = rms_norm(x, g[2])
        if layer < N_A_LAYERS:
            m = short_conv_mixer(h, w_conv_in[layer], w_conv[layer], w_conv_out[layer])
        else:
            j = layer - N_A_LAYERS
            lambda_init = 0.8 - 0.6 * math.exp(-0.3 * layer)
            m = diff_attention(h, k, v, w_q[j], lambda_q1[j], lambda_k1[j], lambda_q2[j],
                               lambda_k2[j], g_subln[j], w_o[j], lambda_init)
        x = x + rms_norm(m, g[3])
        f = swiglu(rms_norm(x, g[4]), w_ffn_gate[layer, 1], w_ffn_up[layer, 1], w_ffn_down[layer, 1])
        x = x + 0.5 * rms_norm(f, g[5])
        if layer == N_A_LAYERS - 1:
            k, v = shared_kv(x, g_kv, w_kv)
    return x
```

```cpp
#include <hip/hip_runtime.h>
#include <hip/hip_cooperative_groups.h>
#include <cstdio>
#include <cstdint>
namespace cg = cooperative_groups;
namespace pg8 {
#define PG8_LAS __attribute__((address_space(3)))
typedef unsigned short bf16_t;
typedef short bf16x8 __attribute__((ext_vector_type(8)));
typedef float f32x4 __attribute__((ext_vector_type(4)));
typedef unsigned u32x4 __attribute__((ext_vector_type(4)));
constexpr int BM = 256, BK = 64, HALF = 128, HTB = HALF * BK * 2  , STAGE_BYTES = 8 * HTB, NXCD = 8, WGM = 8;

__host__ __device__ __forceinline__ int lds_byte(int r, int c) { const int st = (r >> 4) * 2 + (c >> 5), rr = r & 15, cc = c & 31, ob = rr * 64 + cc * 2; return st * 1024 + (ob ^ (((ob >> 9) & 1) << 5)); }
__host__ __device__ __forceinline__ void stage_rc(int b, int& R, int& C) { const int st = b / 1024, sb = b % 1024, swz = sb ^ (((sb >> 9) & 1) << 5); R = (st >> 1) * 16 + swz / 64; C = (st & 1) * 32 + (swz % 64) / 2; }
__host__ __device__ __forceinline__ int perm32(int rho) { const int n = rho >> 4, i = rho & 15; return 8 * (i >> 2) + 4 * n + (i & 3); }

struct Unit { int pm, pn; };
struct Gemm { const bf16_t* A; const bf16_t* Bt; int M, N, K; };

struct StaticOrder {
    int nM, nN, nwg, G, c;
    __host__ __device__ void init(int M, int N, int G_, int c_) { nM = M / BM; nN = N / BM; nwg = nM * nN; G = G_; c = c_; }
    __host__ __device__ bool next(int i, Unit& u) const {
        const long L = (long)i * G + c; if (L >= nwg) return false;
        int wgid = (int)L; { const int q = nwg / NXCD, r = nwg % NXCD, xcd = wgid % NXCD, off = wgid / NXCD; wgid = (xcd < r ? xcd * (q + 1) : r * (q + 1) + (xcd - r) * q) + off; }
        const int nig = WGM * nN, gid = wgid / nig, fm = gid * WGM, gsz = (nM - fm) < WGM ? (nM - fm) : WGM;
        u.pm = fm + ((wgid % nig) % gsz); u.pn = (wgid % nig) / gsz; return true;
    }
    __device__ __forceinline__ void a_ready(const Unit&) const {}
    __device__ __forceinline__ void done(const Unit&) const {}
};

__device__ __forceinline__ unsigned cvt_pk_bf16(float lo, float hi) { unsigned r; asm volatile("v_cvt_pk_bf16_f32 %0, %1, %2" : "=v"(r) : "v"(lo), "v"(hi)); return r; }
__device__ __forceinline__ unsigned pk_bf16(float lo, float hi) { unsigned r; asm("v_cvt_pk_bf16_f32 %0, %1, %2" : "=v"(r) : "v"(lo), "v"(hi)); return r; }
struct EpiBf16P {
    static constexpr bool PERM = true, AFTER_DRAIN = false;
    bf16_t* O; int ldc; int split_cols; size_t split_stride;
    __device__ __forceinline__ void operator()(const f32x4 (&acc)[2][2][4][2], const Unit& u, int wr, int wc, int fr, int fq) const {
        const int row0 = u.pm * BM + wr * 64 + fr; int colt = u.pn * BM; bf16_t* base = O;
        if (split_cols) { const int t = colt / split_cols; base += (size_t)t * split_stride; colt -= t * split_cols; }
        const int col0 = colt + wc * 32 + 8 * fq;
#pragma unroll
        for (int ai = 0; ai < 2; ++ai)
#pragma unroll
            for (int m = 0; m < 4; ++m) { bf16_t* rowp = base + (size_t)(row0 + ai * HALF + m * 16) * ldc + col0;
#pragma unroll
                for (int bj = 0; bj < 2; ++bj) { const f32x4 v0 = acc[ai][bj][m][0], v1 = acc[ai][bj][m][1];
                    u32x4 w; w.x = pk_bf16(v0[0], v0[1]); w.y = pk_bf16(v0[2], v0[3]); w.z = pk_bf16(v1[0], v1[1]); w.w = pk_bf16(v1[2], v1[3]);
                    *(u32x4*)(rowp + bj * HALF) = w; } }
    }
};
__device__ __forceinline__ float silu_mul(float g, float u) { const float e = __builtin_amdgcn_exp2f(-1.4426950408889634f * g); return g * u * __builtin_amdgcn_rcpf(1.0f + e); }
struct EpiSwiglu {
    static constexpr bool PERM = true, AFTER_DRAIN = false;
    bf16_t* H; int ldh;
    __device__ __forceinline__ void operator()(const f32x4 (&acc)[2][2][4][2], const Unit& u, int wr, int wc, int fr, int fq) const {
        const int row0 = u.pm * BM + wr * 64 + fr; const int col0 = u.pn * HALF + wc * 32 + 8 * fq;
#pragma unroll
        for (int ai = 0; ai < 2; ++ai)
#pragma unroll
            for (int m = 0; m < 4; ++m) { bf16_t* rowp = H + (size_t)(row0 + ai * HALF + m * 16) * ldh + col0;
                const f32x4 g0 = acc[ai][0][m][0], g1 = acc[ai][0][m][1], u0 = acc[ai][1][m][0], u1 = acc[ai][1][m][1];
                u32x4 w; w.x = pk_bf16(silu_mul(g0[0], u0[0]), silu_mul(g0[1], u0[1])); w.y = pk_bf16(silu_mul(g0[2], u0[2]), silu_mul(g0[3], u0[3]));
                w.z = pk_bf16(silu_mul(g1[0], u1[0]), silu_mul(g1[1], u1[1])); w.w = pk_bf16(silu_mul(g1[2], u1[2]), silu_mul(g1[3], u1[3]));
                *(u32x4*)rowp = w; }
    }
};
struct EpiF32 {
    static constexpr bool PERM = false, AFTER_DRAIN = false;
    float* F; int ldc;
    __device__ __forceinline__ void operator()(const f32x4 (&acc)[2][2][4][2], const Unit& u, int wr, int wc, int fr, int fq) const {
        const int col0 = u.pn * BM + wc * 32 + 4 * fq;
#pragma unroll
        for (int ai = 0; ai < 2; ++ai)
#pragma unroll
            for (int m = 0; m < 4; ++m) { const size_t off = (size_t)(u.pm * BM + ai * HALF + wr * 64 + m * 16 + fr) * ldc + col0;
#pragma unroll
                for (int bj = 0; bj < 2; ++bj)
#pragma unroll
                    for (int n = 0; n < 2; ++n) *(f32x4*)(F + off + bj * HALF + n * 16) = acc[ai][bj][m][n]; }
    }
};
template <class Epi, class Sched, bool ALIGN_EPI = false, bool SP2 = false>
__device__ __forceinline__ void gemm_phase(PG8_LAS unsigned char* lds, const Gemm g, const Sched& S, const Epi& E) {
    int tid_ = threadIdx.x; asm volatile("" : "+v"(tid_));
    const int tid = tid_, wid = __builtin_amdgcn_readfirstlane(tid >> 6), lane = tid & 63, wr = wid >> 2, wc = wid & 3, fr = lane & 15, fq = lane >> 4;
    const int K = g.K, nt = K / BK;
    unsigned voffA[2], voffB[2];
#pragma unroll
    for (int i = 0; i < 2; ++i) { int R, C; stage_rc(tid * 16 + i * 8192, R, C); const int Rb = Epi::PERM ? ((R & ~31) + perm32(R & 31)) : R;
        voffA[i] = (unsigned)(R * K + C) * 2u; voffB[i] = (unsigned)(Rb * K + C) * 2u; }
    const size_t kstep = (size_t)(BK * 2);
    const size_t hstep = (size_t)HALF * K * 2;
    const size_t tstep = 2 * hstep;
    const unsigned ldsw = (unsigned)wid * 1024u;
    const int aoff = lds_byte(wr * 64 + fr, fq * 8), boff = lds_byte(wc * 32 + fr, fq * 8);
#define PG8_SA(b, h) (((b) * 2 + (h)) * HTB)
#define PG8_SB(b, h) ((4 + (b) * 2 + (h)) * HTB)
#define PG8_STAGE(bufoff, gbase, voff) do { _Pragma("unroll") for (int _i = 0; _i < 2; ++_i) \
        __builtin_amdgcn_global_load_lds((const unsigned*)((const char*)(gbase) + (voff)[_i]), (PG8_LAS unsigned*)(lds + (bufoff) + ldsw + _i * 8192), 16, 0, 0); } while (0)
#define PG8_LDA(dst, b, h) do { _Pragma("unroll") for (int m = 0; m < 4; ++m) _Pragma("unroll") for (int k = 0; k < 2; ++k) dst[m][k] = *(const PG8_LAS bf16x8*)(lds + PG8_SA(b, h) + aoff + m * 2048 + k * 1024); } while (0)
#define PG8_LDB(dst, b, h) do { _Pragma("unroll") for (int n = 0; n < 2; ++n) _Pragma("unroll") for (int k = 0; k < 2; ++k) dst[n][k] = *(const PG8_LAS bf16x8*)(lds + PG8_SB(b, h) + boff + n * 2048 + k * 1024); } while (0)
#define PG8_MMA(ai, bj, At, Bt) do { __builtin_amdgcn_s_setprio(1); _Pragma("unroll") for (int m = 0; m < 4; ++m) _Pragma("unroll") for (int n = 0; n < 2; ++n) _Pragma("unroll") for (int k = 0; k < 2; ++k) \
        acc[ai][bj][m][n] = __builtin_amdgcn_mfma_f32_16x16x32_bf16(Bt[n][k], At[m][k], acc[ai][bj][m][n], 0, 0, 0); __builtin_amdgcn_s_setprio(0); } while (0)
#define PG8_WAIT_V(n) asm volatile("s_waitcnt vmcnt(" #n ")" ::: "memory")
#define PG8_WAIT_L(n) asm volatile("s_waitcnt lgkmcnt(" #n ")" ::: "memory")
#define PG8_BAR __builtin_amdgcn_s_barrier()
#define PG8_SCHED __builtin_amdgcn_sched_barrier(0)
    Unit cur, nxt; int ui = 0;
    if (!S.next(0, cur)) return;
    f32x4 acc[2][2][4][2];
#pragma unroll
    for (int a = 0; a < 2; ++a)
#pragma unroll
        for (int b = 0; b < 2; ++b)
#pragma unroll
            for (int m = 0; m < 4; ++m)
#pragma unroll
                for (int n = 0; n < 2; ++n) acc[a][b][m][n] = (f32x4){0.f, 0.f, 0.f, 0.f};
    bf16x8 At[4][2], B0[2][2], B1[2][2];
    const char* cA = (const char*)g.A + (size_t)cur.pm * tstep; const char* cB = (const char*)g.Bt + (size_t)cur.pn * tstep;
    S.a_ready(cur);
    if constexpr (SP2) {
        PG8_STAGE(PG8_SB(0, 0), cB, voffB); PG8_STAGE(PG8_SB(0, 1), cB + hstep, voffB); PG8_STAGE(PG8_SA(0, 0), cA, voffA); PG8_STAGE(PG8_SA(0, 1), cA + hstep, voffA);
        if (wr == 1) PG8_BAR;
        PG8_WAIT_V(2); PG8_BAR;
        PG8_STAGE(PG8_SB(1, 0), cB + kstep, voffB); PG8_STAGE(PG8_SA(1, 0), cA + kstep, voffA); PG8_STAGE(PG8_SB(1, 1), cB + hstep + kstep, voffB);
        PG8_WAIT_V(6); PG8_BAR;
    } else {
        PG8_STAGE(PG8_SB(0, 0), cB, voffB); PG8_STAGE(PG8_SA(0, 0), cA, voffA); PG8_STAGE(PG8_SB(0, 1), cB + hstep, voffB); PG8_STAGE(PG8_SA(0, 1), cA + hstep, voffA);
        if (wr == 1) PG8_BAR;
        PG8_WAIT_V(4); PG8_BAR;
        PG8_STAGE(PG8_SB(1, 0), cB + kstep, voffB); PG8_STAGE(PG8_SA(1, 0), cA + kstep, voffA); PG8_STAGE(PG8_SB(1, 1), cB + hstep + kstep, voffB);
        PG8_WAIT_V(6); PG8_BAR;
    }
    for (;;) {
        const bool has_next = S.next(ui + 1, nxt);
        const char* nA = has_next ? (const char*)g.A + (size_t)nxt.pm * tstep : cA; const char* nB = has_next ? (const char*)g.Bt + (size_t)nxt.pn * tstep : cB;
        for (int t = 0; t < nt; t += 2) {
            const bool last = (t == nt - 2);
            const char* a1 = cA + (size_t)(t + 1) * kstep;
            const char* a2 = last ? nA : cA + (size_t)(t + 2) * kstep; const char* b2 = last ? nB : cB + (size_t)(t + 2) * kstep;
            const char* a3 = a2 + kstep; const char* b3 = b2 + kstep;
            if (last && has_next) S.a_ready(nxt);
            if constexpr (SP2) {
            PG8_LDB(B0, 0, 0); PG8_LDB(B1, 0, 1); PG8_SCHED; PG8_LDA(At, 0, 0); PG8_STAGE(PG8_SA(1, 1), a1 + hstep, voffA);
            PG8_WAIT_V(8); PG8_WAIT_L(0); PG8_BAR; PG8_MMA(0, 0, At, B0); PG8_MMA(0, 1, At, B1); PG8_BAR; PG8_SCHED;
            PG8_LDA(At, 0, 1); PG8_STAGE(PG8_SB(0, 0), b2, voffB); PG8_STAGE(PG8_SB(0, 1), b2 + hstep, voffB); PG8_STAGE(PG8_SA(0, 0), a2, voffA);
            PG8_WAIT_V(8); PG8_WAIT_L(0); PG8_BAR; PG8_MMA(1, 0, At, B0); PG8_MMA(1, 1, At, B1); PG8_BAR; PG8_SCHED;
            PG8_LDB(B0, 1, 0); PG8_LDB(B1, 1, 1); PG8_SCHED; PG8_LDA(At, 1, 0); PG8_STAGE(PG8_SA(0, 1), a2 + hstep, voffA);
            PG8_WAIT_V(8); PG8_WAIT_L(0); PG8_BAR; PG8_MMA(0, 0, At, B0); PG8_MMA(0, 1, At, B1); PG8_BAR; PG8_SCHED;
            PG8_LDA(At, 1, 1); PG8_STAGE(PG8_SB(1, 0), b3, voffB); PG8_STAGE(PG8_SB(1, 1), b3 + hstep, voffB); PG8_STAGE(PG8_SA(1, 0), a3, voffA);
            PG8_WAIT_V(8); PG8_WAIT_L(0); PG8_BAR; PG8_MMA(1, 0, At, B0); PG8_MMA(1, 1, At, B1); PG8_BAR; PG8_SCHED;
            } else {
            PG8_LDB(B0, 0, 0); PG8_SCHED; PG8_LDA(At, 0, 0); PG8_STAGE(PG8_SA(1, 1), a1 + hstep, voffA);
            PG8_WAIT_L(8); PG8_BAR; PG8_WAIT_L(0); PG8_MMA(0, 0, At, B0); PG8_BAR; PG8_SCHED;
            PG8_LDB(B1, 0, 1); PG8_STAGE(PG8_SB(0, 0), b2, voffB);
            PG8_BAR; PG8_WAIT_L(0); PG8_MMA(0, 1, At, B1); PG8_BAR;
            PG8_LDA(At, 0, 1); PG8_STAGE(PG8_SA(0, 0), a2, voffA);
            PG8_BAR; PG8_WAIT_L(0); PG8_MMA(1, 0, At, B0); PG8_BAR; PG8_SCHED;
            PG8_STAGE(PG8_SB(0, 1), b2 + hstep, voffB);
            PG8_WAIT_V(6); PG8_BAR; PG8_MMA(1, 1, At, B1); PG8_BAR;
            PG8_LDB(B0, 1, 0); PG8_SCHED; PG8_LDA(At, 1, 0); PG8_STAGE(PG8_SA(0, 1), a2 + hstep, voffA);
            PG8_WAIT_L(8); PG8_BAR; PG8_WAIT_L(0); PG8_MMA(0, 0, At, B0); PG8_BAR; PG8_SCHED;
            PG8_LDB(B1, 1, 1); PG8_STAGE(PG8_SB(1, 0), b3, voffB);
            PG8_BAR; PG8_WAIT_L(0); PG8_MMA(0, 1, At, B1); PG8_BAR;
            PG8_LDA(At, 1, 1); PG8_STAGE(PG8_SA(1, 0), a3, voffA);
            PG8_BAR; PG8_WAIT_L(0); PG8_MMA(1, 0, At, B0); PG8_BAR; PG8_SCHED;
            PG8_STAGE(PG8_SB(1, 1), b3 + hstep, voffB);
            PG8_WAIT_V(6); PG8_BAR; PG8_MMA(1, 1, At, B1); PG8_BAR;
            }
        }
        if constexpr (ALIGN_EPI) { if (wr == 0) PG8_BAR; }
        if constexpr (!Epi::AFTER_DRAIN) { E(acc, cur, wr, wc, fr, fq); S.done(cur); }
        if (!has_next) break;
#pragma unroll
        for (int a = 0; a < 2; ++a)
#pragma unroll
            for (int b = 0; b < 2; ++b)
#pragma unroll
                for (int m = 0; m < 4; ++m)
#pragma unroll
                    for (int n = 0; n < 2; ++n) acc[a][b][m][n] = (f32x4){0.f, 0.f, 0.f, 0.f};
        cur = nxt; cA = nA; cB = nB; ++ui;
        if constexpr (ALIGN_EPI) { if (wr == 1) PG8_BAR; }
    }
    PG8_WAIT_V(0);
    if constexpr (!ALIGN_EPI) { if (wr == 0) PG8_BAR; }
    PG8_BAR;
    if constexpr (Epi::AFTER_DRAIN) { E.fused(acc, cur, wr, wc, fr, fq, lds, wid, lane); S.done(cur); }
#undef PG8_SA
#undef PG8_SB
#undef PG8_STAGE
#undef PG8_LDA
#undef PG8_LDB
#undef PG8_MMA
#undef PG8_WAIT_V
#undef PG8_WAIT_L
#undef PG8_BAR
#undef PG8_SCHED
}
}

constexpr int D = 1024, BATCH = 8, SEQ = 2048, M = BATCH * SEQ, FF = 2816, NH = 8;
constexpr float EPS = 1e-6f;
#define LAS __attribute__((address_space(3)))
typedef unsigned short bf16;
typedef short bf16x8 __attribute__((ext_vector_type(8)));
typedef short s16x4 __attribute__((ext_vector_type(4)));
typedef float f32x4 __attribute__((ext_vector_type(4)));
typedef float f32x16 __attribute__((ext_vector_type(16)));
typedef unsigned u32x4 __attribute__((ext_vector_type(4)));
typedef unsigned u32x2 __attribute__((ext_vector_type(2)));
using pg8::pk_bf16;

constexpr size_t MiB = 1u << 20;
constexpr size_t WS_WGU1 = 2 * MiB, WS_WD1 = 13 * MiB, WS_WGU2 = 19 * MiB, WS_WD2 = 30 * MiB, WS_WMA = 36 * MiB, WS_WMB = 42 * MiB, WS_WKV = 44 * MiB;
constexpr size_t WS_XHAT = 50 * MiB, WS_SCR = 82 * MiB, WS_YQO = 178 * MiB, WS_K = 210 * MiB, WS_V = 242 * MiB, WS_F = 274 * MiB, WS_END = 338 * MiB;
constexpr int LDS_BYTES = 147456;
constexpr int NWAVES = 8;

struct Params { const float* in[17]; float* out; unsigned char* ws; };
enum { I_X = 0, I_GN, I_WG, I_WU, I_WDN, I_CIN, I_WC, I_COUT, I_GKV, I_WKV, I_WQ, I_LQ1, I_LK1, I_LQ2, I_LK2, I_GSUB, I_WO };

__device__ __forceinline__ float wave_sum(float v) {
#pragma unroll
    for (int o = 1; o < 64; o <<= 1) v += __shfl_xor(v, o);
    return v;
}
__device__ __forceinline__ int opaque(int v) { asm volatile("" : "+v"(v)); return v; }
__device__ __forceinline__ float bf2f(unsigned short b) { return __uint_as_float((unsigned)b << 16); }

__device__ __forceinline__ void transpose_item(const float* __restrict__ W, int K, int N, bf16* WT, int mode, const float* __restrict__ g, float cs, LAS float* scr, int item, int lane) {
    const int nblk = N / 32, kb = item / nblk, nb = item % nblk, k0 = 64 * kb, n0 = 32 * nb;
    const int drow0 = mode == 0 ? n0 : ((n0 >> 7) * 256 + (n0 & 127) + (mode == 2 ? 128 : 0));
#pragma unroll 8
    for (int i = 0; i < 32; ++i) { const int kk = 2 * i + (lane >> 5); const float s = g ? g[k0 + kk] * cs : cs;
        scr[kk * 33 + (lane & 31)] = W[(size_t)(k0 + kk) * N + n0 + (lane & 31)] * s; }
    asm volatile("s_waitcnt lgkmcnt(0)" ::: "memory");
    const int c = lane & 7;
#pragma unroll
    for (int j = 0; j < 4; ++j) { const int n = (lane >> 3) + 8 * j; const LAS float* s = scr + (8 * c) * 33 + n;
        u32x4 o; o.x = pk_bf16(s[0 * 33], s[1 * 33]); o.y = pk_bf16(s[2 * 33], s[3 * 33]); o.z = pk_bf16(s[4 * 33], s[5 * 33]); o.w = pk_bf16(s[6 * 33], s[7 * 33]);
        *(u32x4*)(WT + (size_t)(drow0 + n) * K + k0 + 8 * c) = o; }
    asm volatile("s_waitcnt lgkmcnt(0)" ::: "memory");
}
__device__ __forceinline__ void convert_job(const float* W, int K, int N, bf16* WT, int mode, const float* g, float cs, LAS float* scr, int gw, int ngw, int lane) {
    const int items = (K / 64) * (N / 32);
    for (int it = gw; it < items; it += ngw) transpose_item(W, K, N, WT, mode, g, cs, scr, it, lane);
}
__device__ __forceinline__ void convert_layer(const Params& p, int layer, LAS unsigned char* lds, int gw, int ngw, int wave, int lane_) {
    const int lane = opaque(lane_);
    LAS float* scr = (LAS float*)(lds + wave * 16384);
    unsigned char* ws = p.ws;
    const float* gn = p.in[I_GN] + (size_t)layer * 6 * D;
#pragma unroll 1
    for (int j = 0; j < 2; ++j) {
        const size_t wo = (size_t)(layer * 2 + j) * D * FF;
        bf16* gu = (bf16*)(ws + (j ? WS_WGU2 : WS_WGU1)); bf16* dn = (bf16*)(ws + (j ? WS_WD2 : WS_WD1));
        const float* g = gn + (j ? 4 : 0) * D;
        convert_job(p.in[I_WG] + wo, D, FF, gu, 1, g, 1.f, scr, gw, ngw, lane);
        convert_job(p.in[I_WU] + wo, D, FF, gu, 2, g, 1.f, scr, gw, ngw, lane);
        convert_job(p.in[I_WDN] + wo, FF, D, dn, 0, nullptr, 1.f, scr, gw, ngw, lane);
    }
    if (layer < 2) {
        convert_job(p.in[I_CIN] + (size_t)layer * D * 3 * D, D, 3 * D, (bf16*)(ws + WS_WMA), 0, gn + 2 * D, 1.f, scr, gw, ngw, lane);
        convert_job(p.in[I_COUT] + (size_t)layer * D * D, D, D, (bf16*)(ws + WS_WMB), 0, nullptr, 1.f, scr, gw, ngw, lane);
    } else {
        convert_job(p.in[I_WQ] + (size_t)(layer - 2) * D * D, D, D, (bf16*)(ws + WS_WMA), 0, gn + 2 * D, 0.125f * 1.4426950408889634f, scr, gw, ngw, lane);
        convert_job(p.in[I_WO] + (size_t)(layer - 2) * D * D, D, D, (bf16*)(ws + WS_WMB), 0, nullptr, 1.f, scr, gw, ngw, lane);
    }
    if (layer == 1) convert_job(p.in[I_WKV], D, 2 * D, (bf16*)(ws + WS_WKV), 0, p.in[I_GKV], 1.f, scr, gw, ngw, lane);
}

__device__ __forceinline__ void rowpass(const float* base, const float* f, const float* gpost, float w, float* xout, bf16* xhat, int gw, int ngw, int lane_) {
    const int lane = opaque(lane_);
    for (int m = gw; m < M; m += ngw) {
        const f32x4* xr = (const f32x4*)(base + (size_t)m * D) + lane;
        f32x4 xv[4];
#pragma unroll
        for (int j = 0; j < 4; ++j) xv[j] = xr[64 * j];
        if (f) {
            const f32x4* fr = (const f32x4*)(f + (size_t)m * D) + lane; const f32x4* gr = (const f32x4*)gpost + lane;
            f32x4 fv[4]; float s = 0.f;
#pragma unroll
            for (int j = 0; j < 4; ++j) { fv[j] = fr[64 * j]; s += (fv[j].x * fv[j].x + fv[j].y * fv[j].y) + (fv[j].z * fv[j].z + fv[j].w * fv[j].w); }
            const float rs = w / sqrtf(wave_sum(s) * (1.f / D) + EPS);
#pragma unroll
            for (int j = 0; j < 4; ++j) { const f32x4 gv = gr[64 * j]; xv[j] = xv[j] + fv[j] * gv * rs; }
            f32x4* xo = (f32x4*)(xout + (size_t)m * D) + lane;
#pragma unroll
            for (int j = 0; j < 4; ++j) xo[64 * j] = xv[j];
        }
        float s2 = 0.f;
#pragma unroll
        for (int j = 0; j < 4; ++j) s2 += (xv[j].x * xv[j].x + xv[j].y * xv[j].y) + (xv[j].z * xv[j].z + xv[j].w * xv[j].w);
        const float rx = 1.f / sqrtf(wave_sum(s2) * (1.f / D) + EPS);
        u32x2* o8 = (u32x2*)(xhat + (size_t)m * D) + lane;
#pragma unroll
        for (int j = 0; j < 4; ++j) { u32x2 o; o.x = pk_bf16(xv[j].x * rx, xv[j].y * rx); o.y = pk_bf16(xv[j].z * rx, xv[j].w * rx); o8[64 * j] = o; }
    }
}

__device__ __forceinline__ void conv_phase(const bf16* BCU, const float* __restrict__ wc, bf16* Y, int G) {
    const int idx = blockIdx.x * 512 + opaque(threadIdx.x);
    for (int it = idx; it < (M / 16) * 128; it += G * 512) {
        const int tg = it >> 7, c0 = (it & 127) * 8, m0 = tg * 16;
        float w0[8], w1[8], w2[8], a[8], b[8];
#pragma unroll
        for (int i = 0; i < 8; ++i) { w0[i] = wc[c0 + i]; w1[i] = wc[D + c0 + i]; w2[i] = wc[2 * D + c0 + i]; a[i] = 0.f; b[i] = 0.f; }
        if ((m0 & (SEQ - 1)) != 0) {
            const bf16x8 c1 = *(const bf16x8*)(BCU + (size_t)(m0 - 2) * 3 * D + D + c0), u1 = *(const bf16x8*)(BCU + (size_t)(m0 - 2) * 3 * D + 2 * D + c0);
            const bf16x8 c2 = *(const bf16x8*)(BCU + (size_t)(m0 - 1) * 3 * D + D + c0), u2 = *(const bf16x8*)(BCU + (size_t)(m0 - 1) * 3 * D + 2 * D + c0);
#pragma unroll
            for (int i = 0; i < 8; ++i) { a[i] = bf2f((unsigned short)c1[i]) * bf2f((unsigned short)u1[i]); b[i] = bf2f((unsigned short)c2[i]) * bf2f((unsigned short)u2[i]); }
        }
#pragma unroll 4
        for (int r = 0; r < 16; ++r) {
            const size_t ro = (size_t)(m0 + r) * 3 * D + c0;
            const bf16x8 bb = *(const bf16x8*)(BCU + ro), cc = *(const bf16x8*)(BCU + ro + D), uu = *(const bf16x8*)(BCU + ro + 2 * D);
            float y[8];
#pragma unroll
            for (int i = 0; i < 8; ++i) { const float cu = bf2f((unsigned short)cc[i]) * bf2f((unsigned short)uu[i]);
                y[i] = bf2f((unsigned short)bb[i]) * (w0[i] * a[i] + w1[i] * b[i] + w2[i] * cu); a[i] = b[i]; b[i] = cu; }
            u32x4 o; o.x = pk_bf16(y[0], y[1]); o.y = pk_bf16(y[2], y[3]); o.z = pk_bf16(y[4], y[5]); o.w = pk_bf16(y[6], y[7]);
            *(u32x4*)(Y + (size_t)(m0 + r) * D + c0) = o;
        }
    }
}

__device__ __forceinline__ int crow(int r, int hi) { return (r & 3) + 8 * (r >> 2) + 4 * hi; }
__device__ __forceinline__ s16x4 vtr(const LAS unsigned char* p) { typedef short v4i16_t __attribute__((ext_vector_type(4))); return __builtin_bit_cast(s16x4, __builtin_amdgcn_ds_read_tr16_b64_v4i16((LAS v4i16_t*)p)); }
#define ATT_WAIT_BAR() asm volatile("s_waitcnt vmcnt(0) lgkmcnt(0)\n\ts_barrier" ::: "memory")
__device__ __forceinline__ void attn_unit(int b, int h, int qb, const bf16* Q, const bf16* __restrict__ Kg, const bf16* __restrict__ Vg, bf16* O, LAS unsigned char* lds,
                                          float lam, float oscale, const float* __restrict__ gsub) {
    const int tid = opaque(threadIdx.x), lane = tid & 63, r32 = lane & 31, hi = lane >> 5;
    const int wid = __builtin_amdgcn_readfirstlane(tid >> 6), c = wid >> 2, g = wid & 3;
    const size_t rowbase = (size_t)b * SEQ; const int q0 = qb * 128, qloc = q0 + 32 * g + r32;
    const bf16* qp = Q + (rowbase + qloc) * D + h * 128 + c * 64 + hi * 8;
    bf16x8 qr[4];
#pragma unroll
    for (int d0 = 0; d0 < 4; ++d0) qr[d0] = *(const bf16x8*)(qp + 16 * d0);
    const int NT = 2 * qb + 2;
    const bf16* ksrc = Kg + (rowbase + lane) * D + h * 128 + (2 * wid) * 8;
    const bf16* vsrc = Vg + (rowbase + 32 * (wid & 1) + (lane >> 2)) * D + h * 128 + 32 * (wid >> 1) + (lane & 3) * 8;
#define ATT_DMA(t, stage) do { const size_t go_ = (size_t)(t) * 64 * D; LAS unsigned char* sb_ = lds + (stage) * 32768 + (2 * wid) * 1024; \
        __builtin_amdgcn_global_load_lds((const unsigned*)(ksrc + go_), (LAS unsigned*)(sb_), 16, 0, 0); \
        __builtin_amdgcn_global_load_lds((const unsigned*)(ksrc + go_ + 8), (LAS unsigned*)(sb_ + 1024), 16, 0, 0); \
        __builtin_amdgcn_global_load_lds((const unsigned*)(vsrc + go_), (LAS unsigned*)(sb_ + 16384), 16, 0, 0); \
        __builtin_amdgcn_global_load_lds((const unsigned*)(vsrc + go_ + 16 * D), (LAS unsigned*)(sb_ + 16384 + 1024), 16, 0, 0); } while (0)
    f32x16 o[4];
#pragma unroll
    for (int i = 0; i < 4; ++i) o[i] = (f32x16){};
    float m_run = -INFINITY, l_run = 0.f;
    const int koff = (c * 8 + hi) * 1024 + r32 * 16;
    const int voff = 16384 + ((lane >> 4) & 1) * 32 + (lane & 3) * 8 + (4 * hi + ((lane & 15) >> 2)) * 64;
    ATT_DMA(0, 0);
#pragma unroll 1
    for (int t = 0; t < NT; ++t) {
        ATT_WAIT_BAR();
        if (t + 1 < NT) ATT_DMA(t + 1, (t + 1) & 1);
        if (64 * t > q0 + 32 * g + 31) continue;
        const LAS unsigned char* st = lds + (t & 1) * 32768;
        f32x16 p0 = (f32x16){}, p1 = (f32x16){};
#pragma unroll
        for (int d0 = 0; d0 < 4; ++d0) {
            const bf16x8 ka = *(const LAS bf16x8*)(st + koff + d0 * 2048), kb = *(const LAS bf16x8*)(st + koff + d0 * 2048 + 512);
            p0 = __builtin_amdgcn_mfma_f32_32x32x16_bf16(ka, qr[d0], p0, 0, 0, 0);
            p1 = __builtin_amdgcn_mfma_f32_32x32x16_bf16(kb, qr[d0], p1, 0, 0, 0);
        }
        if (t >= NT - 2) {
            const int kb0 = 64 * t + 4 * hi;
#pragma unroll
            for (int r = 0; r < 16; ++r) { const int kv = kb0 + (r & 3) + 8 * (r >> 2); if (kv > qloc) p0[r] = -INFINITY; if (kv + 32 > qloc) p1[r] = -INFINITY; }
        }
        float mx = fmaxf(p0[0], p1[0]);
#pragma unroll
        for (int r = 1; r < 16; ++r) mx = fmaxf(mx, fmaxf(p0[r], p1[r]));
        mx = fmaxf(mx, __shfl_xor(mx, 32));
        if (__any(mx > m_run)) {
            const float mn = fmaxf(m_run, mx), al = __builtin_amdgcn_exp2f(m_run - mn);
            m_run = mn; l_run *= al;
#pragma unroll
            for (int i = 0; i < 4; ++i)
#pragma unroll
                for (int r = 0; r < 16; ++r) o[i][r] *= al;
        }
        float ls = 0.f;
#pragma unroll
        for (int r = 0; r < 16; ++r) { p0[r] = __builtin_amdgcn_exp2f(p0[r] - m_run); p1[r] = __builtin_amdgcn_exp2f(p1[r] - m_run); ls += p0[r] + p1[r]; }
        l_run += ls;
        bf16x8 pw[4];
        { u32x4 w;
          w.x = pk_bf16(p0[0], p0[1]); w.y = pk_bf16(p0[2], p0[3]); w.z = pk_bf16(p0[4], p0[5]); w.w = pk_bf16(p0[6], p0[7]); pw[0] = __builtin_bit_cast(bf16x8, w);
          w.x = pk_bf16(p0[8], p0[9]); w.y = pk_bf16(p0[10], p0[11]); w.z = pk_bf16(p0[12], p0[13]); w.w = pk_bf16(p0[14], p0[15]); pw[1] = __builtin_bit_cast(bf16x8, w);
          w.x = pk_bf16(p1[0], p1[1]); w.y = pk_bf16(p1[2], p1[3]); w.z = pk_bf16(p1[4], p1[5]); w.w = pk_bf16(p1[6], p1[7]); pw[2] = __builtin_bit_cast(bf16x8, w);
          w.x = pk_bf16(p1[8], p1[9]); w.y = pk_bf16(p1[10], p1[11]); w.z = pk_bf16(p1[12], p1[13]); w.w = pk_bf16(p1[14], p1[15]); pw[3] = __builtin_bit_cast(bf16x8, w); }
#pragma unroll
        for (int blk = 0; blk < 4; ++blk)
#pragma unroll
            for (int ks = 0; ks < 4; ++ks) {
                const LAS unsigned char* vp = st + voff + (blk * 4 + ks) * 1024;
                const s16x4 lo = vtr(vp), hh = vtr(vp + 512);
                const bf16x8 vf = (bf16x8){lo[0], lo[1], lo[2], lo[3], hh[0], hh[1], hh[2], hh[3]};
                o[blk] = __builtin_amdgcn_mfma_f32_32x32x16_bf16(vf, pw[ks], o[blk], 0, 0, 0);
            }
    }
    l_run += __shfl_xor(l_run, 32);
    const float inv = 1.0f / l_run;
    LAS float* X = (LAS float*)(lds + 65536) + (size_t)g * 4096 + lane;
    if (c == 1) {
        const float s = lam * inv;
#pragma unroll
        for (int blk = 0; blk < 4; ++blk)
#pragma unroll
            for (int r = 0; r < 16; ++r) X[(blk * 16 + r) * 64] = o[blk][r] * s;
    }
    ATT_WAIT_BAR();
    if (c == 0) {
        float ss = 0.f;
#pragma unroll
        for (int blk = 0; blk < 4; ++blk)
#pragma unroll
            for (int r = 0; r < 16; ++r) { const float d = o[blk][r] * inv - X[(blk * 16 + r) * 64]; o[blk][r] = d; ss += d * d; }
        ss += __shfl_xor(ss, 32);
        const float rs = oscale / sqrtf(ss * (1.f / 128.f) + EPS);
        bf16* op = O + (rowbase + qloc) * D + h * 128 + 4 * hi;
#pragma unroll
        for (int blk = 0; blk < 4; ++blk)
#pragma unroll
            for (int j = 0; j < 4; ++j) { const int e = 32 * blk + 8 * j + 4 * hi; const f32x4 gv = *(const f32x4*)(gsub + e);
                u32x2 w; w.x = pk_bf16(o[blk][4 * j] * rs * gv.x, o[blk][4 * j + 1] * rs * gv.y); w.y = pk_bf16(o[blk][4 * j + 2] * rs * gv.z, o[blk][4 * j + 3] * rs * gv.w);
                *(u32x2*)(op + 32 * blk + 8 * j) = w; }
    }
#undef ATT_DMA
}
__device__ __forceinline__ void attn_phase(const Params& p, int layer, LAS unsigned char* lds, int vcu, int lane_) {
    const int lane = opaque(lane_);
    const int j = layer - 2;
    const float lambda_init = 0.8f - 0.6f * expf(-0.3f * (float)layer);
    float s1 = p.in[I_LQ1][j * 64 + lane] * p.in[I_LK1][j * 64 + lane], s2 = p.in[I_LQ2][j * 64 + lane] * p.in[I_LK2][j * 64 + lane];
    s1 = wave_sum(s1); s2 = wave_sum(s2);
    const float lam = expf(s1) - expf(s2) + lambda_init;
    const bf16* Q = (const bf16*)(p.ws + WS_YQO); const bf16* Kg = (const bf16*)(p.ws + WS_K); const bf16* Vg = (const bf16*)(p.ws + WS_V);
#pragma unroll 1
    for (int it = vcu; it < 1024; it += (int)gridDim.x) {
        const int v = it & 255, i = it >> 8, bh = v >> 2, s = v & 3;
        const int qb = (i == 0) ? s : (i == 1) ? 7 - s : (i == 2) ? 8 + s : 15 - s;
        attn_unit(bh >> 3, bh & 7, qb, Q, Kg, Vg, (bf16*)(p.ws + WS_YQO), lds, lam, 1.0f - lambda_init, p.in[I_GSUB] + j * 128);
    }
}

__global__ void __launch_bounds__(512, 2) fwd_megakernel(Params p) {
    extern __shared__ __attribute__((aligned(16))) unsigned char lds_raw[];
    LAS unsigned char* lds = (LAS unsigned char*)lds_raw;
    cg::grid_group grid = cg::this_grid();
    const int tid = threadIdx.x, lane = tid & 63, wave = __builtin_amdgcn_readfirstlane(tid >> 6);
    const int G = gridDim.x, bx = blockIdx.x;
    const int vcu = (G % 8 == 0) ? (bx % 8) * (G / 8) + bx / 8 : bx;
    const int gw = vcu * NWAVES + wave, ngw = G * NWAVES;
    unsigned char* ws = p.ws;
    bf16* XHAT = (bf16*)(ws + WS_XHAT); bf16* SCR = (bf16*)(ws + WS_SCR); bf16* YQO = (bf16*)(ws + WS_YQO); float* FB = (float*)(ws + WS_F);
    const float* gnorm = p.in[I_GN];

    convert_layer(p, 0, lds, gw, ngw, wave, lane);
    rowpass(p.in[I_X], nullptr, nullptr, 0.f, nullptr, XHAT, gw, ngw, lane);
    grid.sync();

#pragma unroll 1
    for (int s = 0; s < 13; ++s) {
        const bool kvstep = (s == 6);
        const int step = s < 6 ? s : s - 1, layer = step / 3, sub = step % 3;
        if (!kvstep && sub != 1) {
            { pg8::Gemm g{XHAT, (const bf16*)(ws + (sub ? WS_WGU2 : WS_WGU1)), M, 2 * FF, D}; pg8::StaticOrder S; S.init(M, 2 * FF, G, bx);
              pg8::EpiSwiglu E{SCR, FF};
              pg8::gemm_phase<pg8::EpiSwiglu, pg8::StaticOrder, true, true>(lds, g, S, E); }
            grid.sync();
            { pg8::Gemm g{SCR, (const bf16*)(ws + (sub ? WS_WD2 : WS_WD1)), M, D, FF}; pg8::StaticOrder S; S.init(M, D, G, bx);
              pg8::EpiF32 E{FB, D};
              pg8::gemm_phase<pg8::EpiF32, pg8::StaticOrder, true, true>(lds, g, S, E); }
        } else {
            const int kind = kvstep ? 2 : (layer < 2 ? 0 : 1);
            const int N1 = kind == 0 ? 3 * D : (kind == 1 ? D : 2 * D);
            { pg8::Gemm g{XHAT, (const bf16*)(ws + (kind == 2 ? WS_WKV : WS_WMA)), M, N1, D}; pg8::StaticOrder S; S.init(M, N1, G, bx);
              pg8::EpiBf16P E{kind == 0 ? SCR : (kind == 1 ? YQO : (bf16*)(ws + WS_K)), kind == 0 ? 3 * D : D, kind == 2 ? D : 0, (size_t)(WS_V - WS_K) / 2};
              pg8::gemm_phase<pg8::EpiBf16P, pg8::StaticOrder, true, true>(lds, g, S, E); }
            if (kvstep) continue;
            grid.sync();
            if (kind == 0) conv_phase(SCR, p.in[I_WC] + (size_t)layer * 3 * D, YQO, G);
            else attn_phase(p, layer, lds, vcu, lane);
            grid.sync();
            { pg8::Gemm g{YQO, (const bf16*)(ws + WS_WMB), M, D, D}; pg8::StaticOrder S; S.init(M, D, G, bx);
              pg8::EpiF32 E{FB, D};
              pg8::gemm_phase<pg8::EpiF32, pg8::StaticOrder, true, true>(lds, g, S, E); }
        }
        grid.sync();
        rowpass(step == 0 ? p.in[I_X] : p.out, FB, gnorm + (size_t)(layer * 6 + 2 * sub + 1) * D, sub == 1 ? 1.0f : 0.5f, p.out, XHAT, gw, ngw, lane);
        if (sub == 2 && layer < 3) convert_layer(p, layer + 1, lds, gw, ngw, wave, lane);
        grid.sync();
    }
}

extern "C" void kernel_launch(void* const* d_in, const int* in_sizes, int n_in, void* d_out, int out_size, void* d_ws, size_t ws_size, hipStream_t stream) {
    static int grid = 0;
    if (grid == 0) {
        if (n_in != 17 || out_size != M * D || ws_size < WS_END) { fprintf(stderr, "kernel_launch: unexpected shapes (n_in %d out %d ws %zu)\n", n_in, out_size, ws_size); grid = -1; return; }
        int dev = 0, cus = 0, per_cu = 0;
        hipGetDevice(&dev); hipDeviceGetAttribute(&cus, hipDeviceAttributeMultiprocessorCount, dev);
        hipFuncSetAttribute((const void*)fwd_megakernel, hipFuncAttributeMaxDynamicSharedMemorySize, LDS_BYTES);
        hipOccupancyMaxActiveBlocksPerMultiprocessor(&per_cu, (const void*)fwd_megakernel, 512, LDS_BYTES);
        if (per_cu < 1) per_cu = 1;
        grid = cus * per_cu;
        (void)hipGetLastError();
    }
    if (grid < 0) return;
    Params p{};
    for (int i = 0; i < 17; ++i) p.in[i] = (const float*)d_in[i];
    p.out = (float*)d_out; p.ws = (unsigned char*)d_ws;
    void* args[] = {&p};
    hipError_t e = hipLaunchCooperativeKernel((void*)fwd_megakernel, dim3(grid), dim3(512), args, LDS_BYTES, stream);
    if (e != hipSuccess) fprintf(stderr, "cooperative launch failed: %s (grid %d)\n", hipGetErrorString(e), grid);
}
```

```cpp
#include <hip/hip_runtime.h>
#include <hip/hip_cooperative_groups.h>
#include <cstdio>
#include <cstdint>
namespace cg = cooperative_groups;
namespace pg8 {
#define PG8_LAS __attribute__((address_space(3)))
typedef unsigned short bf16_t;
typedef short bf16x8 __attribute__((ext_vector_type(8)));
typedef float f32x4 __attribute__((ext_vector_type(4)));
typedef unsigned u32x4 __attribute__((ext_vector_type(4)));
constexpr int BM = 256, BK = 64, HALF = 128, HTB = HALF * BK * 2  , STAGE_BYTES = 8 * HTB, NXCD = 8, WGM = 8;

__host__ __device__ __forceinline__ int lds_byte(int r, int c) { const int st = (r >> 4) * 2 + (c >> 5), rr = r & 15, cc = c & 31, ob = rr * 64 + cc * 2; return st * 1024 + (ob ^ (((ob >> 9) & 1) << 5)); }
__host__ __device__ __forceinline__ void stage_rc(int b, int& R, int& C) { const int st = b / 1024, sb = b % 1024, swz = sb ^ (((sb >> 9) & 1) << 5); R = (st >> 1) * 16 + swz / 64; C = (st & 1) * 32 + (swz % 64) / 2; }
__host__ __device__ __forceinline__ int perm32(int rho) { const int n = rho >> 4, i = rho & 15; return 8 * (i >> 2) + 4 * n + (i & 3); }

struct Unit { int pm, pn; };
struct Gemm { const bf16_t* A; const bf16_t* Bt; int M, N, K; };

struct StaticOrder {
    int nM, nN, nwg, G, c;
    __host__ __device__ void init(int M, int N, int G_, int c_) { nM = M / BM; nN = N / BM; nwg = nM * nN; G = G_; c = c_; }
    __host__ __device__ bool next(int i, Unit& u) const {
        const long L = (long)i * G + c; if (L >= nwg) return false;
        int wgid = (int)L; { const int q = nwg / NXCD, r = nwg % NXCD, xcd = wgid % NXCD, off = wgid / NXCD; wgid = (xcd < r ? xcd * (q + 1) : r * (q + 1) + (xcd - r) * q) + off; }
        const int nig = WGM * nN, gid = wgid / nig, fm = gid * WGM, gsz = (nM - fm) < WGM ? (nM - fm) : WGM;
        u.pm = fm + ((wgid % nig) % gsz); u.pn = (wgid % nig) / gsz; return true;
    }
    __device__ __forceinline__ void a_ready(const Unit&) const {}
    __device__ __forceinline__ void done(const Unit&) const {}
};

__device__ __forceinline__ unsigned cvt_pk_bf16(float lo, float hi) { unsigned r; asm volatile("v_cvt_pk_bf16_f32 %0, %1, %2" : "=v"(r) : "v"(lo), "v"(hi)); return r; }
__device__ __forceinline__ unsigned pk_bf16(float lo, float hi) { unsigned r; asm("v_cvt_pk_bf16_f32 %0, %1, %2" : "=v"(r) : "v"(lo), "v"(hi)); return r; }
struct EpiBf16P {
    static constexpr bool PERM = true, AFTER_DRAIN = false;
    bf16_t* O; int ldc; int split_cols; size_t split_stride;
    __device__ __forceinline__ void operator()(const f32x4 (&acc)[2][2][4][2], const Unit& u, int wr, int wc, int fr, int fq) const {
        const int row0 = u.pm * BM + wr * 64 + fr; int colt = u.pn * BM; bf16_t* base = O;
        if (split_cols) { const int t = colt / split_cols; base += (size_t)t * split_stride; colt -= t * split_cols; }
        const int col0 = colt + wc * 32 + 8 * fq;
#pragma unroll
        for (int ai = 0; ai < 2; ++ai)
#pragma unroll
            for (int m = 0; m < 4; ++m) { bf16_t* rowp = base + (size_t)(row0 + ai * HALF + m * 16) * ldc + col0;
#pragma unroll
                for (int bj = 0; bj < 2; ++bj) { const f32x4 v0 = acc[ai][bj][m][0], v1 = acc[ai][bj][m][1];
                    u32x4 w; w.x = pk_bf16(v0[0], v0[1]); w.y = pk_bf16(v0[2], v0[3]); w.z = pk_bf16(v1[0], v1[1]); w.w = pk_bf16(v1[2], v1[3]);
                    *(u32x4*)(rowp + bj * HALF) = w; } }
    }
};
__device__ __forceinline__ float silu_mul(float g, float u) { const float e = __builtin_amdgcn_exp2f(-1.4426950408889634f * g); return g * u * __builtin_amdgcn_rcpf(1.0f + e); }
struct EpiSwiglu {
    static constexpr bool PERM = true, AFTER_DRAIN = false;
    bf16_t* H; int ldh;
    __device__ __forceinline__ void operator()(const f32x4 (&acc)[2][2][4][2], const Unit& u, int wr, int wc, int fr, int fq) const {
        const int row0 = u.pm * BM + wr * 64 + fr; const int col0 = u.pn * HALF + wc * 32 + 8 * fq;
#pragma unroll
        for (int ai = 0; ai < 2; ++ai)
#pragma unroll
            for (int m = 0; m < 4; ++m) { bf16_t* rowp = H + (size_t)(row0 + ai * HALF + m * 16) * ldh + col0;
                const f32x4 g0 = acc[ai][0][m][0], g1 = acc[ai][0][m][1], u0 = acc[ai][1][m][0], u1 = acc[ai][1][m][1];
                u32x4 w; w.x = pk_bf16(silu_mul(g0[0], u0[0]), silu_mul(g0[1], u0[1])); w.y = pk_bf16(silu_mul(g0[2], u0[2]), silu_mul(g0[3], u0[3]));
                w.z = pk_bf16(silu_mul(g1[0], u1[0]), silu_mul(g1[1], u1[1])); w.w = pk_bf16(silu_mul(g1[2], u1[2]), silu_mul(g1[3], u1[3]));
                *(u32x4*)rowp = w; }
    }
};
struct EpiF32 {
    static constexpr bool PERM = false, AFTER_DRAIN = false;
    float* F; int ldc;
    __device__ __forceinline__ void operator()(const f32x4 (&acc)[2][2][4][2], const Unit& u, int wr, int wc, int fr, int fq) const {
        const int col0 = u.pn * BM + wc * 32 + 4 * fq;
#pragma unroll
        for (int ai = 0; ai < 2; ++ai)
#pragma unroll
            for (int m = 0; m < 4; ++m) { const size_t off = (size_t)(u.pm * BM + ai * HALF + wr * 64 + m * 16 + fr) * ldc + col0;
#pragma unroll
                for (int bj = 0; bj < 2; ++bj)
#pragma unroll
                    for (int n = 0; n < 2; ++n) *(f32x4*)(F + off + bj * HALF + n * 16) = acc[ai][bj][m][n]; }
    }
};
template <class Epi, class Sched, bool ALIGN_EPI = false, bool SP2 = false>
__device__ __forceinline__ void gemm_phase(PG8_LAS unsigned char* lds, const Gemm g, const Sched& S, const Epi& E) {
    int tid_ = threadIdx.x; asm volatile("" : "+v"(tid_));
    const int tid = tid_, wid = __builtin_amdgcn_readfirstlane(tid >> 6), lane = tid & 63, wr = wid >> 2, wc = wid & 3, fr = lane & 15, fq = lane >> 4;
    const int K = g.K, nt = K / BK;
    unsigned voffA[2], voffB[2];
#pragma unroll
    for (int i = 0; i < 2; ++i) { int R, C; stage_rc(tid * 16 + i * 8192, R, C); const int Rb = Epi::PERM ? ((R & ~31) + perm32(R & 31)) : R;
        voffA[i] = (unsigned)(R * K + C) * 2u; voffB[i] = (unsigned)(Rb * K + C) * 2u; }
    const size_t kstep = (size_t)(BK * 2);
    const size_t hstep = (size_t)HALF * K * 2;
    const size_t tstep = 2 * hstep;
    const unsigned ldsw = (unsigned)wid * 1024u;
    const int aoff = lds_byte(wr * 64 + fr, fq * 8), boff = lds_byte(wc * 32 + fr, fq * 8);
#define PG8_SA(b, h) (((b) * 2 + (h)) * HTB)
#define PG8_SB(b, h) ((4 + (b) * 2 + (h)) * HTB)
#define PG8_STAGE(bufoff, gbase, voff) do { _Pragma("unroll") for (int _i = 0; _i < 2; ++_i) \
        __builtin_amdgcn_global_load_lds((const unsigned*)((const char*)(gbase) + (voff)[_i]), (PG8_LAS unsigned*)(lds + (bufoff) + ldsw + _i * 8192), 16, 0, 0); } while (0)
#define PG8_LDA(dst, b, h) do { _Pragma("unroll") for (int m = 0; m < 4; ++m) _Pragma("unroll") for (int k = 0; k < 2; ++k) dst[m][k] = *(const PG8_LAS bf16x8*)(lds + PG8_SA(b, h) + aoff + m * 2048 + k * 1024); } while (0)
#define PG8_LDB(dst, b, h) do { _Pragma("unroll") for (int n = 0; n < 2; ++n) _Pragma("unroll") for (int k = 0; k < 2; ++k) dst[n][k] = *(const PG8_LAS bf16x8*)(lds + PG8_SB(b, h) + boff + n * 2048 + k * 1024); } while (0)
#define PG8_MMA(ai, bj, At, Bt) do { __builtin_amdgcn_s_setprio(1); _Pragma("unroll") for (int m = 0; m < 4; ++m) _Pragma("unroll") for (int n = 0; n < 2; ++n) _Pragma("unroll") for (int k = 0; k < 2; ++k) \
        acc[ai][bj][m][n] = __builtin_amdgcn_mfma_f32_16x16x32_bf16(Bt[n][k], At[m][k], acc[ai][bj][m][n], 0, 0, 0); __builtin_amdgcn_s_setprio(0); } while (0)
#define PG8_WAIT_V(n) asm volatile("s_waitcnt vmcnt(" #n ")" ::: "memory")
#define PG8_WAIT_L(n) asm volatile("s_waitcnt lgkmcnt(" #n ")" ::: "memory")
#define PG8_BAR __builtin_amdgcn_s_barrier()
#define PG8_SCHED __builtin_amdgcn_sched_barrier(0)
    Unit cur, nxt; int ui = 0;
    if (!S.next(0, cur)) return;
    f32x4 acc[2][2][4][2];
#pragma unroll
    for (int a = 0; a < 2; ++a)
#pragma unroll
        for (int b = 0; b < 2; ++b)
#pragma unroll
            for (int m = 0; m < 4; ++m)
#pragma unroll
                for (int n = 0; n < 2; ++n) acc[a][b][m][n] = (f32x4){0.f, 0.f, 0.f, 0.f};
    bf16x8 At[4][2], B0[2][2], B1[2][2];
    const char* cA = (const char*)g.A + (size_t)cur.pm * tstep; const char* cB = (const char*)g.Bt + (size_t)cur.pn * tstep;
    S.a_ready(cur);
    if constexpr (SP2) {
        PG8_STAGE(PG8_SB(0, 0), cB, voffB); PG8_STAGE(PG8_SB(0, 1), cB + hstep, voffB); PG8_STAGE(PG8_SA(0, 0), cA, voffA); PG8_STAGE(PG8_SA(0, 1), cA + hstep, voffA);
        if (wr == 1) PG8_BAR;
        PG8_WAIT_V(2); PG8_BAR;
        PG8_STAGE(PG8_SB(1, 0), cB + kstep, voffB); PG8_STAGE(PG8_SA(1, 0), cA + kstep, voffA); PG8_STAGE(PG8_SB(1, 1), cB + hstep + kstep, voffB);
        PG8_WAIT_V(6); PG8_BAR;
    } else {
        PG8_STAGE(PG8_SB(0, 0), cB, voffB); PG8_STAGE(PG8_SA(0, 0), cA, voffA); PG8_STAGE(PG8_SB(0, 1), cB + hstep, voffB); PG8_STAGE(PG8_SA(0, 1), cA + hstep, voffA);
        if (wr == 1) PG8_BAR;
        PG8_WAIT_V(4); PG8_BAR;
        PG8_STAGE(PG8_SB(1, 0), cB + kstep, voffB); PG8_STAGE(PG8_SA(1, 0), cA + kstep, voffA); PG8_STAGE(PG8_SB(1, 1), cB + hstep + kstep, voffB);
        PG8_WAIT_V(6); PG8_BAR;
    }
    for (;;) {
        const bool has_next = S.next(ui + 1, nxt);
        const char* nA = has_next ? (const char*)g.A + (size_t)nxt.pm * tstep : cA; const char* nB = has_next ? (const char*)g.Bt + (size_t)nxt.pn * tstep : cB;
        for (int t = 0; t < nt; t += 2) {
            const bool last = (t == nt - 2);
            const char* a1 = cA + (size_t)(t + 1) * kstep;
            const char* a2 = last ? nA : cA + (size_t)(t + 2) * kstep; const char* b2 = last ? nB : cB + (size_t)(t + 2) * kstep;
            const char* a3 = a2 + kstep; const char* b3 = b2 + kstep;
            if (last && has_next) S.a_ready(nxt);
            if constexpr (SP2) {
            PG8_LDB(B0, 0, 0); PG8_LDB(B1, 0, 1); PG8_SCHED; PG8_LDA(At, 0, 0); PG8_STAGE(PG8_SA(1, 1), a1 + hstep, voffA);
            PG8_WAIT_V(8); PG8_WAIT_L(0); PG8_BAR; PG8_MMA(0, 0, At, B0); PG8_MMA(0, 1, At, B1); PG8_BAR; PG8_SCHED;
            PG8_LDA(At, 0, 1); PG8_STAGE(PG8_SB(0, 0), b2, voffB); PG8_STAGE(PG8_SB(0, 1), b2 + hstep, voffB); PG8_STAGE(PG8_SA(0, 0), a2, voffA);
            PG8_WAIT_V(8); PG8_WAIT_L(0); PG8_BAR; PG8_MMA(1, 0, At, B0); PG8_MMA(1, 1, At, B1); PG8_BAR; PG8_SCHED;
            PG8_LDB(B0, 1, 0); PG8_LDB(B1, 1, 1); PG8_SCHED; PG8_LDA(At, 1, 0); PG8_STAGE(PG8_SA(0, 1), a2 + hstep, voffA);
            PG8_WAIT_V(8); PG8_WAIT_L(0); PG8_BAR; PG8_MMA(0, 0, At, B0); PG8_MMA(0, 1, At, B1); PG8_BAR; PG8_SCHED;
            PG8_LDA(At, 1, 1); PG8_STAGE(PG8_SB(1, 0), b3, voffB); PG8_STAGE(PG8_SB(1, 1), b3 + hstep, voffB); PG8_STAGE(PG8_SA(1, 0), a3, voffA);
            PG8_WAIT_V(8); PG8_WAIT_L(0); PG8_BAR; PG8_MMA(1, 0, At, B0); PG8_MMA(1, 1, At, B1); PG8_BAR; PG8_SCHED;
            } else {
            PG8_LDB(B0, 0, 0); PG8_SCHED; PG8_LDA(At, 0, 0); PG8_STAGE(PG8_SA(1, 1), a1 + hstep, voffA);
            PG8_WAIT_L(8); PG8_BAR; PG8_WAIT_L(0); PG8_MMA(0, 0, At, B0); PG8_BAR; PG8_SCHED;
            PG8_LDB(B1, 0, 1); PG8_STAGE(PG8_SB(0, 0), b2, voffB);
            PG8_BAR; PG8_WAIT_L(0); PG8_MMA(0, 1, At, B1); PG8_BAR;
            PG8_LDA(At, 0, 1); PG8_STAGE(PG8_SA(0, 0), a2, voffA);
            PG8_BAR; PG8_WAIT_L(0); PG8_MMA(1, 0, At, B0); PG8_BAR; PG8_SCHED;
            PG8_STAGE(PG8_SB(0, 1), b2 + hstep, voffB);
            PG8_WAIT_V(6); PG8_BAR; PG8_MMA(1, 1, At, B1); PG8_BAR;
            PG8_LDB(B0, 1, 0); PG8_SCHED; PG8_LDA(At, 1, 0); PG8_STAGE(PG8_SA(0, 1), a2 + hstep, voffA);
            PG8_WAIT_L(8); PG8_BAR; PG8_WAIT_L(0); PG8_MMA(0, 0, At, B0); PG8_BAR; PG8_SCHED;
            PG8_LDB(B1, 1, 1); PG8_STAGE(PG8_SB(1, 0), b3, voffB);
            PG8_BAR; PG8_WAIT_L(0); PG8_MMA(0, 1, At, B1); PG8_BAR;
            PG8_LDA(At, 1, 1); PG8_STAGE(PG8_SA(1, 0), a3, voffA);
            PG8_BAR; PG8_WAIT_L(0); PG8_MMA(1, 0, At, B0); PG8_BAR; PG8_SCHED;
            PG8_STAGE(PG8_SB(1, 1), b3 + hstep, voffB);
            PG8_WAIT_V(6); PG8_BAR; PG8_MMA(1, 1, At, B1); PG8_BAR;
            }
        }
        if constexpr (ALIGN_EPI) { if (wr == 0) PG8_BAR; }
        if constexpr (!Epi::AFTER_DRAIN) { E(acc, cur, wr, wc, fr, fq); S.done(cur); }
        if (!has_next) break;
#pragma unroll
        for (int a = 0; a < 2; ++a)
#pragma unroll
            for (int b = 0; b < 2; ++b)
#pragma unroll
                for (int m = 0; m < 4; ++m)
#pragma unroll
                    for (int n = 0; n < 2; ++n) acc[a][b][m][n] = (f32x4){0.f, 0.f, 0.f, 0.f};
        cur = nxt; cA = nA; cB = nB; ++ui;
        if constexpr (ALIGN_EPI) { if (wr == 1) PG8_BAR; }
    }
    PG8_WAIT_V(0);
    if constexpr (!ALIGN_EPI) { if (wr == 0) PG8_BAR; }
    PG8_BAR;
    if constexpr (Epi::AFTER_DRAIN) { E.fused(acc, cur, wr, wc, fr, fq, lds, wid, lane); S.done(cur); }
#undef PG8_SA
#undef PG8_SB
#undef PG8_STAGE
#undef PG8_LDA
#undef PG8_LDB
#undef PG8_MMA
#undef PG8_WAIT_V
#undef PG8_WAIT_L
#undef PG8_BAR
#undef PG8_SCHED
}
}

constexpr int D = 1024, BATCH = 8, SEQ = 2048, M = BATCH * SEQ, FF = 2816, NH = 8;
constexpr float EPS = 1e-6f;
#define LAS __attribute__((address_space(3)))
typedef unsigned short bf16;
typedef short bf16x8 __attribute__((ext_vector_type(8)));
typedef short s16x4 __attribute__((ext_vector_type(4)));
typedef float f32x4 __attribute__((ext_vector_type(4)));
typedef float f32x16 __attribute__((ext_vector_type(16)));
typedef unsigned u32x4 __attribute__((ext_vector_type(4)));
typedef unsigned u32x2 __attribute__((ext_vector_type(2)));
using pg8::pk_bf16;

constexpr size_t MiB = 1u << 20;
constexpr size_t WS_WGU1 = 2 * MiB, WS_WD1 = 13 * MiB, WS_WGU2 = 19 * MiB, WS_WD2 = 30 * MiB, WS_WMA = 36 * MiB, WS_WMB = 42 * MiB, WS_WKV = 44 * MiB;
constexpr size_t WS_XHAT = 50 * MiB, WS_SCR = 82 * MiB, WS_YQO = 178 * MiB, WS_K = 210 * MiB, WS_V = 242 * MiB, WS_F = 274 * MiB, WS_END = 338 * MiB;
constexpr int LDS_BYTES = 147456, LDSCTL_OFF = 131072;
constexpr size_t CTL_ZERO_BYTES = 65536;
constexpr int NWAVES = 8;

struct Params { const float* in[17]; float* out; unsigned char* ws; };
enum { I_X = 0, I_GN, I_WG, I_WU, I_WDN, I_CIN, I_WC, I_COUT, I_GKV, I_WKV, I_WQ, I_LQ1, I_LK1, I_LQ2, I_LK2, I_GSUB, I_WO };

__device__ __forceinline__ float wave_sum(float v) {
#pragma unroll
    for (int o = 1; o < 64; o <<= 1) v += __shfl_xor(v, o);
    return v;
}
__device__ __forceinline__ int opaque(int v) { asm volatile("" : "+v"(v)); return v; }
__device__ __forceinline__ float bf2f(unsigned short b) { return __uint_as_float((unsigned)b << 16); }

__device__ __forceinline__ void transpose_item(const float* __restrict__ W, int K, int N, bf16* WT, int mode, const float* __restrict__ g, float cs, LAS float* scr, int item, int lane) {
    const int nblk = N / 32, kb = item / nblk, nb = item % nblk, k0 = 64 * kb, n0 = 32 * nb;
    const int drow0 = mode == 0 ? n0 : ((n0 >> 7) * 256 + (n0 & 127) + (mode == 2 ? 128 : 0));
#pragma unroll 8
    for (int i = 0; i < 32; ++i) { const int kk = 2 * i + (lane >> 5); const float s = g ? g[k0 + kk] * cs : cs;
        scr[kk * 33 + (lane & 31)] = W[(size_t)(k0 + kk) * N + n0 + (lane & 31)] * s; }
    asm volatile("s_waitcnt lgkmcnt(0)" ::: "memory");
    const int c = lane & 7;
#pragma unroll
    for (int j = 0; j < 4; ++j) { const int n = (lane >> 3) + 8 * j; const LAS float* s = scr + (8 * c) * 33 + n;
        u32x4 o; o.x = pk_bf16(s[0 * 33], s[1 * 33]); o.y = pk_bf16(s[2 * 33], s[3 * 33]); o.z = pk_bf16(s[4 * 33], s[5 * 33]); o.w = pk_bf16(s[6 * 33], s[7 * 33]);
        *(u32x4*)(WT + (size_t)(drow0 + n) * K + k0 + 8 * c) = o; }
    asm volatile("s_waitcnt lgkmcnt(0)" ::: "memory");
}
__device__ __forceinline__ void convert_job(const float* W, int K, int N, bf16* WT, int mode, const float* g, float cs, LAS float* scr, int gw, int ngw, int lane) {
    const int items = (K / 64) * (N / 32);
    for (int it = gw; it < items; it += ngw) transpose_item(W, K, N, WT, mode, g, cs, scr, it, lane);
}
__device__ __forceinline__ void convert_layer(const Params& p, int layer, LAS unsigned char* lds, int gw, int ngw, int wave, int lane_) {
    const int lane = opaque(lane_);
    LAS float* scr = (LAS float*)(lds + wave * 16384);
    unsigned char* ws = p.ws;
    const float* gn = p.in[I_GN] + (size_t)layer * 6 * D;
#pragma unroll 1
    for (int j = 0; j < 2; ++j) {
        const size_t wo = (size_t)(layer * 2 + j) * D * FF;
        bf16* gu = (bf16*)(ws + (j ? WS_WGU2 : WS_WGU1)); bf16* dn = (bf16*)(ws + (j ? WS_WD2 : WS_WD1));
        const float* g = gn + (j ? 4 : 0) * D;
        convert_job(p.in[I_WG] + wo, D, FF, gu, 1, g, 1.f, scr, gw, ngw, lane);
        convert_job(p.in[I_WU] + wo, D, FF, gu, 2, g, 1.f, scr, gw, ngw, lane);
        convert_job(p.in[I_WDN] + wo, FF, D, dn, 0, nullptr, 1.f, scr, gw, ngw, lane);
    }
    if (layer < 2) {
        convert_job(p.in[I_CIN] + (size_t)layer * D * 3 * D, D, 3 * D, (bf16*)(ws + WS_WMA), 0, gn + 2 * D, 1.f, scr, gw, ngw, lane);
        convert_job(p.in[I_COUT] + (size_t)layer * D * D, D, D, (bf16*)(ws + WS_WMB), 0, nullptr, 1.f, scr, gw, ngw, lane);
    } else {
        convert_job(p.in[I_WQ] + (size_t)(layer - 2) * D * D, D, D, (bf16*)(ws + WS_WMA), 0, gn + 2 * D, 0.125f * 1.4426950408889634f, scr, gw, ngw, lane);
        convert_job(p.in[I_WO] + (size_t)(layer - 2) * D * D, D, D, (bf16*)(ws + WS_WMB), 0, nullptr, 1.f, scr, gw, ngw, lane);
    }
    if (layer == 1) convert_job(p.in[I_WKV], D, 2 * D, (bf16*)(ws + WS_WKV), 0, p.in[I_GKV], 1.f, scr, gw, ngw, lane);
}

__device__ __forceinline__ void rowpass(const float* base, const float* f, const float* gpost, float w, float* xout, bf16* xhat, int gw, int ngw, int lane_) {
    const int lane = opaque(lane_);
    for (int m = gw; m < M; m += ngw) {
        const f32x4* xr = (const f32x4*)(base + (size_t)m * D) + lane;
        f32x4 xv[4];
#pragma unroll
        for (int j = 0; j < 4; ++j) xv[j] = xr[64 * j];
        if (f) {
            const f32x4* fr = (const f32x4*)(f + (size_t)m * D) + lane; const f32x4* gr = (const f32x4*)gpost + lane;
            f32x4 fv[4]; float s = 0.f;
#pragma unroll
            for (int j = 0; j < 4; ++j) { fv[j] = fr[64 * j]; s += (fv[j].x * fv[j].x + fv[j].y * fv[j].y) + (fv[j].z * fv[j].z + fv[j].w * fv[j].w); }
            const float rs = w / sqrtf(wave_sum(s) * (1.f / D) + EPS);
#pragma unroll
            for (int j = 0; j < 4; ++j) { const f32x4 gv = gr[64 * j]; xv[j] = xv[j] + fv[j] * gv * rs; }
            f32x4* xo = (f32x4*)(xout + (size_t)m * D) + lane;
#pragma unroll
            for (int j = 0; j < 4; ++j) xo[64 * j] = xv[j];
        }
        float s2 = 0.f;
#pragma unroll
        for (int j = 0; j < 4; ++j) s2 += (xv[j].x * xv[j].x + xv[j].y * xv[j].y) + (xv[j].z * xv[j].z + xv[j].w * xv[j].w);
        const float rx = 1.f / sqrtf(wave_sum(s2) * (1.f / D) + EPS);
        u32x2* o8 = (u32x2*)(xhat + (size_t)m * D) + lane;
#pragma unroll
        for (int j = 0; j < 4; ++j) { u32x2 o; o.x = pk_bf16(xv[j].x * rx, xv[j].y * rx); o.y = pk_bf16(xv[j].z * rx, xv[j].w * rx); o8[64 * j] = o; }
    }
}

__device__ __forceinline__ void conv_phase(const bf16* BCU, const float* __restrict__ wc, bf16* Y, int G) {
    const int idx = blockIdx.x * 512 + opaque(threadIdx.x);
    for (int it = idx; it < (M / 16) * 128; it += G * 512) {
        const int tg = it >> 7, c0 = (it & 127) * 8, m0 = tg * 16;
        float w0[8], w1[8], w2[8], a[8], b[8];
#pragma unroll
        for (int i = 0; i < 8; ++i) { w0[i] = wc[c0 + i]; w1[i] = wc[D + c0 + i]; w2[i] = wc[2 * D + c0 + i]; a[i] = 0.f; b[i] = 0.f; }
        if ((m0 & (SEQ - 1)) != 0) {
            const bf16x8 c1 = *(const bf16x8*)(BCU + (size_t)(m0 - 2) * 3 * D + D + c0), u1 = *(const bf16x8*)(BCU + (size_t)(m0 - 2) * 3 * D + 2 * D + c0);
            const bf16x8 c2 = *(const bf16x8*)(BCU + (size_t)(m0 - 1) * 3 * D + D + c0), u2 = *(const bf16x8*)(BCU + (size_t)(m0 - 1) * 3 * D + 2 * D + c0);
#pragma unroll
            for (int i = 0; i < 8; ++i) { a[i] = bf2f((unsigned short)c1[i]) * bf2f((unsigned short)u1[i]); b[i] = bf2f((unsigned short)c2[i]) * bf2f((unsigned short)u2[i]); }
        }
#pragma unroll 4
        for (int r = 0; r < 16; ++r) {
            const size_t ro = (size_t)(m0 + r) * 3 * D + c0;
            const bf16x8 bb = *(const bf16x8*)(BCU + ro), cc = *(const bf16x8*)(BCU + ro + D), uu = *(const bf16x8*)(BCU + ro + 2 * D);
            float y[8];
#pragma unroll
            for (int i = 0; i < 8; ++i) { const float cu = bf2f((unsigned short)cc[i]) * bf2f((unsigned short)uu[i]);
                y[i] = bf2f((unsigned short)bb[i]) * (w0[i] * a[i] + w1[i] * b[i] + w2[i] * cu); a[i] = b[i]; b[i] = cu; }
            u32x4 o; o.x = pk_bf16(y[0], y[1]); o.y = pk_bf16(y[2], y[3]); o.z = pk_bf16(y[4], y[5]); o.w = pk_bf16(y[6], y[7]);
            *(u32x4*)(Y + (size_t)(m0 + r) * D + c0) = o;
        }
    }
}

__device__ __forceinline__ int crow(int r, int hi) { return (r & 3) + 8 * (r >> 2) + 4 * hi; }
__device__ __forceinline__ s16x4 vtr(const LAS unsigned char* p) { typedef short v4i16_t __attribute__((ext_vector_type(4))); return __builtin_bit_cast(s16x4, __builtin_amdgcn_ds_read_tr16_b64_v4i16((LAS v4i16_t*)p)); }
#define ATT_WAIT_BAR() asm volatile("s_waitcnt vmcnt(0) lgkmcnt(0)\n\ts_barrier" ::: "memory")
__device__ __forceinline__ void attn_unit(int b, int h, int qb, const bf16* Q, const bf16* __restrict__ Kg, const bf16* __restrict__ Vg, bf16* O, LAS unsigned char* lds,
                                          float lam, float oscale, const float* __restrict__ gsub) {
    const int tid = opaque(threadIdx.x), lane = tid & 63, r32 = lane & 31, hi = lane >> 5;
    const int wid = __builtin_amdgcn_readfirstlane(tid >> 6), c = wid >> 2, g = wid & 3;
    const size_t rowbase = (size_t)b * SEQ; const int q0 = qb * 128, qloc = q0 + 32 * g + r32;
    const bf16* qp = Q + (rowbase + qloc) * D + h * 128 + c * 64 + hi * 8;
    bf16x8 qr[4];
#pragma unroll
    for (int d0 = 0; d0 < 4; ++d0) qr[d0] = *(const bf16x8*)(qp + 16 * d0);
    const int NT = 2 * qb + 2;
    const bf16* ksrc = Kg + (rowbase + lane) * D + h * 128 + (2 * wid) * 8;
    const bf16* vsrc = Vg + (rowbase + 32 * (wid & 1) + (lane >> 2)) * D + h * 128 + 32 * (wid >> 1) + (lane & 3) * 8;
#define ATT_DMA(t, stage) do { const size_t go_ = (size_t)(t) * 64 * D; LAS unsigned char* sb_ = lds + (stage) * 32768 + (2 * wid) * 1024; \
        __builtin_amdgcn_global_load_lds((const unsigned*)(ksrc + go_), (LAS unsigned*)(sb_), 16, 0, 0); \
        __builtin_amdgcn_global_load_lds((const unsigned*)(ksrc + go_ + 8), (LAS unsigned*)(sb_ + 1024), 16, 0, 0); \
        __builtin_amdgcn_global_load_lds((const unsigned*)(vsrc + go_), (LAS unsigned*)(sb_ + 16384), 16, 0, 0); \
        __builtin_amdgcn_global_load_lds((const unsigned*)(vsrc + go_ + 16 * D), (LAS unsigned*)(sb_ + 16384 + 1024), 16, 0, 0); } while (0)
    f32x16 o[4];
#pragma unroll
    for (int i = 0; i < 4; ++i) o[i] = (f32x16){};
    float m_run = -INFINITY, l_run = 0.f;
    const int koff = (c * 8 + hi) * 1024 + r32 * 16;
    const int voff = 16384 + ((lane >> 4) & 1) * 32 + (lane & 3) * 8 + (4 * hi + ((lane & 15) >> 2)) * 64;
    ATT_DMA(0, 0);
#pragma unroll 1
    for (int t = 0; t < NT; ++t) {
        ATT_WAIT_BAR();
        if (t + 1 < NT) ATT_DMA(t + 1, (t + 1) & 1);
        if (64 * t > q0 + 32 * g + 31) continue;
        const LAS unsigned char* st = lds + (t & 1) * 32768;
        f32x16 p0 = (f32x16){}, p1 = (f32x16){};
#pragma unroll
        for (int d0 = 0; d0 < 4; ++d0) {
            const bf16x8 ka = *(const LAS bf16x8*)(st + koff + d0 * 2048), kb = *(const LAS bf16x8*)(st + koff + d0 * 2048 + 512);
            p0 = __builtin_amdgcn_mfma_f32_32x32x16_bf16(ka, qr[d0], p0, 0, 0, 0);
            p1 = __builtin_amdgcn_mfma_f32_32x32x16_bf16(kb, qr[d0], p1, 0, 0, 0);
        }
        if (t >= NT - 2) {
            const int kb0 = 64 * t + 4 * hi;
#pragma unroll
            for (int r = 0; r < 16; ++r) { const int kv = kb0 + (r & 3) + 8 * (r >> 2); if (kv > qloc) p0[r] = -INFINITY; if (kv + 32 > qloc) p1[r] = -INFINITY; }
        }
        float mx = fmaxf(p0[0], p1[0]);
#pragma unroll
        for (int r = 1; r < 16; ++r) mx = fmaxf(mx, fmaxf(p0[r], p1[r]));
        mx = fmaxf(mx, __shfl_xor(mx, 32));
        if (__any(mx > m_run)) {
            const float mn = fmaxf(m_run, mx), al = __builtin_amdgcn_exp2f(m_run - mn);
            m_run = mn; l_run *= al;
#pragma unroll
            for (int i = 0; i < 4; ++i)
#pragma unroll
                for (int r = 0; r < 16; ++r) o[i][r] *= al;
        }
        float ls = 0.f;
#pragma unroll
        for (int r = 0; r < 16; ++r) { p0[r] = __builtin_amdgcn_exp2f(p0[r] - m_run); p1[r] = __builtin_amdgcn_exp2f(p1[r] - m_run); ls += p0[r] + p1[r]; }
        l_run += ls;
        bf16x8 pw[4];
        { u32x4 w;
          w.x = pk_bf16(p0[0], p0[1]); w.y = pk_bf16(p0[2], p0[3]); w.z = pk_bf16(p0[4], p0[5]); w.w = pk_bf16(p0[6], p0[7]); pw[0] = __builtin_bit_cast(bf16x8, w);
          w.x = pk_bf16(p0[8], p0[9]); w.y = pk_bf16(p0[10], p0[11]); w.z = pk_bf16(p0[12], p0[13]); w.w = pk_bf16(p0[14], p0[15]); pw[1] = __builtin_bit_cast(bf16x8, w);
          w.x = pk_bf16(p1[0], p1[1]); w.y = pk_bf16(p1[2], p1[3]); w.z = pk_bf16(p1[4], p1[5]); w.w = pk_bf16(p1[6], p1[7]); pw[2] = __builtin_bit_cast(bf16x8, w);
          w.x = pk_bf16(p1[8], p1[9]); w.y = pk_bf16(p1[10], p1[11]); w.z = pk_bf16(p1[12], p1[13]); w.w = pk_bf16(p1[14], p1[15]); pw[3] = __builtin_bit_cast(bf16x8, w); }
#pragma unroll
        for (int blk = 0; blk < 4; ++blk)
#pragma unroll
            for (int ks = 0; ks < 4; ++ks) {
                const LAS unsigned char* vp = st + voff + (blk * 4 + ks) * 1024;
                const s16x4 lo = vtr(vp), hh = vtr(vp + 512);
                const bf16x8 vf = (bf16x8){lo[0], lo[1], lo[2], lo[3], hh[0], hh[1], hh[2], hh[3]};
                o[blk] = __builtin_amdgcn_mfma_f32_32x32x16_bf16(vf, pw[ks], o[blk], 0, 0, 0);
            }
    }
    l_run += __shfl_xor(l_run, 32);
    const float inv = 1.0f / l_run;
    LAS float* X = (LAS float*)(lds + 65536) + (size_t)g * 4096 + lane;
    if (c == 1) {
        const float s = lam * inv;
#pragma unroll
        for (int blk = 0; blk < 4; ++blk)
#pragma unroll
            for (int r = 0; r < 16; ++r) X[(blk * 16 + r) * 64] = o[blk][r] * s;
    }
    ATT_WAIT_BAR();
    if (c == 0) {
        float ss = 0.f;
#pragma unroll
        for (int blk = 0; blk < 4; ++blk)
#pragma unroll
            for (int r = 0; r < 16; ++r) { const float d = o[blk][r] * inv - X[(blk * 16 + r) * 64]; o[blk][r] = d; ss += d * d; }
        ss += __shfl_xor(ss, 32);
        const float rs = oscale / sqrtf(ss * (1.f / 128.f) + EPS);
        bf16* op = O + (rowbase + qloc) * D + h * 128 + 4 * hi;
#pragma unroll
        for (int blk = 0; blk < 4; ++blk)
#pragma unroll
            for (int j = 0; j < 4; ++j) { const int e = 32 * blk + 8 * j + 4 * hi; const f32x4 gv = *(const f32x4*)(gsub + e);
                u32x2 w; w.x = pk_bf16(o[blk][4 * j] * rs * gv.x, o[blk][4 * j + 1] * rs * gv.y); w.y = pk_bf16(o[blk][4 * j + 2] * rs * gv.z, o[blk][4 * j + 3] * rs * gv.w);
                *(u32x2*)(op + 32 * blk + 8 * j) = w; }
    }
#undef ATT_DMA
}
__device__ __forceinline__ void attn_phase(const Params& p, int layer, LAS unsigned char* lds, int vcu, int lane_) {
    const int lane = opaque(lane_);
    const int j = layer - 2;
    const float lambda_init = 0.8f - 0.6f * expf(-0.3f * (float)layer);
    float s1 = p.in[I_LQ1][j * 64 + lane] * p.in[I_LK1][j * 64 + lane], s2 = p.in[I_LQ2][j * 64 + lane] * p.in[I_LK2][j * 64 + lane];
    s1 = wave_sum(s1); s2 = wave_sum(s2);
    const float lam = expf(s1) - expf(s2) + lambda_init;
    const bf16* Q = (const bf16*)(p.ws + WS_YQO); const bf16* Kg = (const bf16*)(p.ws + WS_K); const bf16* Vg = (const bf16*)(p.ws + WS_V);
#pragma unroll 1
    for (int it = vcu; it < 1024; it += (int)gridDim.x) {
        const int v = it & 255, i = it >> 8, bh = v >> 2, s = v & 3;
        const int qb = (i == 0) ? s : (i == 1) ? 7 - s : (i == 2) ? 8 + s : 15 - s;
        attn_unit(bh >> 3, bh & 7, qb, Q, Kg, Vg, (bf16*)(p.ws + WS_SCR), lds, lam, 1.0f - lambda_init, p.in[I_GSUB] + j * 128);
    }
}

#define XB_TMO      128
#define XB_XCNT(j)  (256  + 64 * (j))
#define XB_XSUB(j)  (1280 + 64 * (j))
#define XB_XGEN(j)  (2304 + 64 * (j))
#define XB_TOP      3328
#define XB_TOPGEN   3392
#define XCD_BAR_WORDS 3456
#define XB_SPIN_CAP (1u << 18)

__device__ __forceinline__ unsigned xb_ld(unsigned* p)              { return __hip_atomic_load(p, __ATOMIC_RELAXED, __HIP_MEMORY_SCOPE_AGENT); }
__device__ __forceinline__ unsigned xb_add(unsigned* p, unsigned v) { return __hip_atomic_fetch_add(p, v, __ATOMIC_RELAXED, __HIP_MEMORY_SCOPE_AGENT); }
__device__ __forceinline__ unsigned xb_xcc_id() { return (unsigned)__builtin_amdgcn_s_getreg((3 << 11) | 20) & 0xFu; }
#define XB_SPIN(cond, bar) do { unsigned _sp = 0; while (cond) { __builtin_amdgcn_s_sleep(1); \
    if ((++_sp & 255u) == 0u) { if (xb_ld(&(bar)[XB_TMO])) break; if (_sp > XB_SPIN_CAP) { atomicAdd(&(bar)[XB_TMO], 1u); break; } } } } while (0)

struct XcdBarrier {
    unsigned* bar; unsigned x;
    volatile LAS unsigned* st;
};

__device__ __forceinline__ XcdBarrier xcd_barrier_post(unsigned* bar, volatile LAS unsigned* st) {
    XcdBarrier b; b.bar = bar; b.x = xb_xcc_id(); b.st = st;
    if (threadIdx.x == 0) (void)xb_add(&bar[XB_XCNT(b.x)], 1u);
    return b;
}
__device__ __forceinline__ void xcd_barrier_complete(unsigned* bar, unsigned x, unsigned& nloc, unsigned& nx) {
    const unsigned G = gridDim.x * gridDim.y * gridDim.z;
    unsigned sum, cnt, mine, sp = 0u;
    for (;;) {
        sum = 0u; cnt = 0u; mine = 0u;
#pragma unroll
        for (unsigned j = 0; j < 16; ++j) { const unsigned c = xb_ld(&bar[XB_XCNT(j)]); sum += c; cnt += (c > 0u) ? 1u : 0u; mine = (j == x) ? c : mine; }
        if (sum == G) break;
        __builtin_amdgcn_s_sleep(1);
        if ((++sp & 255u) == 0u) { if (xb_ld(&bar[XB_TMO])) break; if (sp > XB_SPIN_CAP) { atomicAdd(&bar[XB_TMO], 1u); break; } }
    }
    nloc = mine > 0u ? mine : 1u; nx = cnt > 0u ? cnt : 1u;
}

__device__ __forceinline__ void xcd_barrier(const XcdBarrier& b) {
    asm volatile("s_waitcnt vmcnt(0)" ::: "memory");
    __syncthreads();
    if (threadIdx.x == 0) {
        unsigned* bar = b.bar;
        __builtin_amdgcn_s_waitcnt(0);
        unsigned nloc = b.st[0], nx = b.st[1];
        if (nloc == 0u) { xcd_barrier_complete(bar, b.x, nloc, nx); b.st[0] = nloc; b.st[1] = nx; }
        const unsigned old = xb_add(&bar[XB_XSUB(b.x)], 1u);
        const unsigned gen = old / nloc;
        if (old + 1u == (gen + 1u) * nloc) {
            __builtin_amdgcn_fence(__ATOMIC_RELEASE, "agent");
            asm volatile("s_waitcnt vmcnt(0)" ::: "memory");
            const unsigned og = xb_add(&bar[XB_TOP], 1u);
            const unsigned tg = og / nx;
            if (og + 1u == (tg + 1u) * nx) xb_add(&bar[XB_TOPGEN], 1u);
            else XB_SPIN(xb_ld(&bar[XB_TOPGEN]) == tg, bar);
            __builtin_amdgcn_fence(__ATOMIC_ACQUIRE, "agent");
            xb_add(&bar[XB_XGEN(b.x)], 1u);
            asm volatile("s_waitcnt vmcnt(0)" ::: "memory");
        } else {
            XB_SPIN(xb_ld(&bar[XB_XGEN(b.x)]) == gen, bar);
            __builtin_amdgcn_fence(__ATOMIC_ACQUIRE, "agent");
            asm volatile("s_waitcnt vmcnt(0)" ::: "memory");
        }
    }
    __syncthreads();
}

#define PROBE_GEMM2 0
#define PROBE_SYNC2 0
#define PROBE_ATT2 0
#define GEMM_REP (PROBE_GEMM2 ? 2 : 1)
__global__ void __launch_bounds__(512, 2) fwd_megakernel(Params p) {
    extern __shared__ __attribute__((aligned(16))) unsigned char lds_raw[];
    LAS unsigned char* lds = (LAS unsigned char*)lds_raw;
    cg::grid_group grid = cg::this_grid();
    const int tid = threadIdx.x, lane = tid & 63, wave = __builtin_amdgcn_readfirstlane(tid >> 6);
    const int G = gridDim.x, bx = blockIdx.x;
    const int vcu = (G % 8 == 0) ? (bx % 8) * (G / 8) + bx / 8 : bx;
    const int gw = vcu * NWAVES + wave, ngw = G * NWAVES;
    unsigned char* ws = p.ws;
    bf16* XHAT = (bf16*)(ws + WS_XHAT); bf16* SCR = (bf16*)(ws + WS_SCR); bf16* YQO = (bf16*)(ws + WS_YQO); float* FB = (float*)(ws + WS_F);
    const float* gnorm = p.in[I_GN];
    if (tid < 32) ((LAS unsigned*)(lds + LDSCTL_OFF))[tid] = 0u;
    __syncthreads();
    const XcdBarrier bar = xcd_barrier_post((unsigned*)ws, (volatile LAS unsigned*)(lds + LDSCTL_OFF + 32));
#define GRID_BAR() xcd_barrier(bar)

    convert_layer(p, 0, lds, gw, ngw, wave, lane);
    rowpass(p.in[I_X], nullptr, nullptr, 0.f, nullptr, XHAT, gw, ngw, lane);
    grid.sync();

#pragma unroll 1
    for (int s = 0; s < 13; ++s) {
        const bool kvstep = (s == 6);
        const int step = s < 6 ? s : s - 1, layer = step / 3, sub = step % 3;
        if (!kvstep && sub != 1) {
            { pg8::Gemm g{XHAT, (const bf16*)(ws + (sub ? WS_WGU2 : WS_WGU1)), M, 2 * FF, D}; pg8::StaticOrder S; S.init(M, 2 * FF, G, bx);
              pg8::EpiSwiglu E{SCR, FF};
              for (int rep_ = 0; rep_ < GEMM_REP; ++rep_) pg8::gemm_phase<pg8::EpiSwiglu, pg8::StaticOrder, true, true>(lds, g, S, E); }
            GRID_BAR();
            { pg8::Gemm g{SCR, (const bf16*)(ws + (sub ? WS_WD2 : WS_WD1)), M, D, FF}; pg8::StaticOrder S; S.init(M, D, G, bx);
              pg8::EpiF32 E{FB, D};
              for (int rep_ = 0; rep_ < GEMM_REP; ++rep_) pg8::gemm_phase<pg8::EpiF32, pg8::StaticOrder, true, true>(lds, g, S, E); }
        } else {
            const int kind = kvstep ? 2 : (layer < 2 ? 0 : 1);
            const int N1 = kind == 0 ? 3 * D : (kind == 1 ? D : 2 * D);
            { pg8::Gemm g{XHAT, (const bf16*)(ws + (kind == 2 ? WS_WKV : WS_WMA)), M, N1, D}; pg8::StaticOrder S; S.init(M, N1, G, bx);
              pg8::EpiBf16P E{kind == 0 ? SCR : (kind == 1 ? YQO : (bf16*)(ws + WS_K)), kind == 0 ? 3 * D : D, kind == 2 ? D : 0, (size_t)(WS_V - WS_K) / 2};
              for (int rep_ = 0; rep_ < GEMM_REP; ++rep_) pg8::gemm_phase<pg8::EpiBf16P, pg8::StaticOrder, true, true>(lds, g, S, E); }
            if (kvstep) continue;
            GRID_BAR();
            if (kind == 0) conv_phase(SCR, p.in[I_WC] + (size_t)layer * 3 * D, YQO, G);
            else { attn_phase(p, layer, lds, vcu, lane); if (PROBE_ATT2) attn_phase(p, layer, lds, vcu, lane); }
            GRID_BAR();
            { pg8::Gemm g{kind == 0 ? YQO : SCR, (const bf16*)(ws + WS_WMB), M, D, D}; pg8::StaticOrder S; S.init(M, D, G, bx);
              pg8::EpiF32 E{FB, D};
              for (int rep_ = 0; rep_ < GEMM_REP; ++rep_) pg8::gemm_phase<pg8::EpiF32, pg8::StaticOrder, true, true>(lds, g, S, E); }
        }
        GRID_BAR(); if (PROBE_SYNC2) { GRID_BAR(); GRID_BAR(); GRID_BAR(); GRID_BAR(); }
        rowpass(step == 0 ? p.in[I_X] : p.out, FB, gnorm + (size_t)(layer * 6 + 2 * sub + 1) * D, sub == 1 ? 1.0f : 0.5f, p.out, XHAT, gw, ngw, lane);
        if (sub == 2 && layer < 3) convert_layer(p, layer + 1, lds, gw, ngw, wave, lane);
        GRID_BAR();
    }
}

extern "C" void kernel_launch(void* const* d_in, const int* in_sizes, int n_in, void* d_out, int out_size, void* d_ws, size_t ws_size, hipStream_t stream) {
    static int grid = 0;
    if (grid == 0) {
        if (n_in != 17 || out_size != M * D || ws_size < WS_END) { fprintf(stderr, "kernel_launch: unexpected shapes (n_in %d out %d ws %zu)\n", n_in, out_size, ws_size); grid = -1; return; }
        int dev = 0, cus = 0, per_cu = 0;
        hipGetDevice(&dev); hipDeviceGetAttribute(&cus, hipDeviceAttributeMultiprocessorCount, dev);
        hipFuncSetAttribute((const void*)fwd_megakernel, hipFuncAttributeMaxDynamicSharedMemorySize, LDS_BYTES);
        hipOccupancyMaxActiveBlocksPerMultiprocessor(&per_cu, (const void*)fwd_megakernel, 512, LDS_BYTES);
        if (per_cu < 1) per_cu = 1;
        grid = cus * per_cu;
        (void)hipGetLastError();
    }
    if (grid < 0) return;
    if (hipMemsetAsync(d_ws, 0, CTL_ZERO_BYTES, stream) != hipSuccess) { fprintf(stderr, "kernel_launch: memset of the barrier words failed\n"); return; }
    Params p{};
    for (int i = 0; i < 17; ++i) p.in[i] = (const float*)d_in[i];
    p.out = (float*)d_out; p.ws = (unsigned char*)d_ws;
    void* args[] = {&p};
    hipError_t e = hipLaunchCooperativeKernel((void*)fwd_megakernel, dim3(grid), dim3(512), args, LDS_BYTES, stream);
    if (e != hipSuccess) fprintf(stderr, "cooperative launch failed: %s (grid %d)\n", hipGetErrorString(e), grid);
}
```
